# Optimizing an MI355X kernel written in HIP

```python
import math
import jax, jax.numpy as jnp
from jax import lax
import numpy as np

D_MODEL = 1024
BATCH = 4
SEQ = 4096
DEPTH = 1
DEC_BATCH = 32
DEC_SEQ = 1
PAST_LEN = 16384
PAGE_SIZE = 128

RET_DK = 256
RET_HEADS = D_MODEL // RET_DK
RET_DV = 2 * RET_DK
RET_QK = RET_HEADS * RET_DK
RET_V = RET_HEADS * RET_DV
RET_CHUNK = 128
ROPE_BASE = 10000.0
ATT_GROUPS = ((128, 1), (512, 4), (2048, 16))
N_GROUPS = len(ATT_GROUPS)
ATT_HPG = 4
ATT_HD = 128
ATT_HEADS = N_GROUPS * ATT_HPG
ATT_W = ATT_HEADS * ATT_HD
ATT_OUT = ATT_HPG * ATT_HD
ATT_STREAM_WIN = 128
FFN_HIDDEN = -(-8 * D_MODEL // (3 * 256)) * 256
EPS = 1e-6
IN_WIDTHS = (RET_QK, RET_QK, RET_V, RET_V, ATT_W, ATT_W, ATT_W, D_MODEL, D_MODEL)
IN_TOTAL = sum(IN_WIDTHS)
IN_SPLIT_IDX = tuple(int(c) for c in np.cumsum(IN_WIDTHS)[:-1])

kernel_name = "retnet_longnet_gated_hybrid"


def rmsnorm(x, g):
    xf = x.astype(jnp.float32)
    y = xf * lax.rsqrt(jnp.mean(xf * xf, axis=-1, keepdims=True) + EPS)
    return (y * g.astype(jnp.float32)).astype(x.dtype)


def rotary(x, pos):
    half = x.shape[-1] // 2
    inv = ROPE_BASE ** (-jnp.arange(half, dtype=jnp.float32) / half)
    ang = pos.astype(jnp.float32)[:, None] * inv[None, :]
    cos = jnp.cos(ang)[None, :, None, :]
    sin = jnp.sin(ang)[None, :, None, :]
    x1, x2 = x[..., :half], x[..., half:]
    return jnp.concatenate([x1 * cos - x2 * sin, x1 * sin + x2 * cos], axis=-1)


def retention(q, k, v, s0, chunk):
    B, T, H, dk = q.shape
    dv = v.shape[-1]
    n = T // chunk
    lg = jnp.log(1.0 - 2.0 ** (-5.0 - jnp.arange(H, dtype=jnp.float32)))
    i = jnp.arange(chunk, dtype=jnp.float32)
    diff = i[:, None] - i[None, :]
    d_intra = jnp.where(diff >= 0, jnp.exp(lg[:, None, None] * jnp.maximum(diff, 0.0)), 0.0)
    q_dec = jnp.exp(lg[:, None] * (i + 1.0))[:, :, None]
    k_dec = jnp.exp(lg[:, None] * (chunk - 1.0 - i))[:, :, None]
    c_dec = jnp.exp(lg * chunk)[:, None, None]

    def to_chunks(a):
        return a.reshape(B, n, chunk, H, a.shape[-1]).transpose(1, 0, 3, 2, 4)

    def step(S, xs):
        qc, kc, vc = xs
        sc = jnp.einsum("bhid,bhjd->bhij", qc, kc) * d_intra
        o = jnp.einsum("bhij,bhjv->bhiv", sc, vc) + jnp.einsum("bhid,bhdv->bhiv", qc * q_dec, S)
        S_new = S * c_dec + jnp.einsum("bhjd,bhjv->bhdv", kc * k_dec, vc)
        return S_new, o

    s_fin, o = lax.scan(step, s0, (to_chunks(q), to_chunks(k), to_chunks(v)))
    o = o.transpose(1, 0, 3, 2, 4).reshape(B, T, H, dv)
    return o, s_fin


def dilated_prompt(q, k, v, dil):
    B, T, H, E = q.shape
    M = ATT_STREAM_WIN
    L = T // dil
    nb = -(-L // M)
    Lp = nb * M

    def stream(a):
        a = a.reshape(B, L, dil, H, E).transpose(0, 2, 1, 3, 4)
        return jnp.pad(a, ((0, 0), (0, 0), (0, Lp - L), (0, 0), (0, 0)))

    def band(a):
        a = jnp.pad(stream(a), ((0, 0), (0, 0), (M, 0), (0, 0), (0, 0)))
        prev = a[:, :, :Lp].reshape(B, dil, nb, M, H, E)
        cur = a[:, :, M:].reshape(B, dil, nb, M, H, E)
        return jnp.concatenate([prev, cur], axis=3)

    qs = stream(q).reshape(B, dil, nb, M, H, E)
    kb, vb = band(k), band(v)
    s = jnp.einsum("bdnihe,bdnjhe->bdnhij", qs, kb) * (E ** -0.5)
    ii = jnp.arange(M)[None, :, None]
    jj = jnp.arange(2 * M)[None, None, :]
    blk = jnp.arange(nb)[:, None, None]
    off = ii + M - jj
    valid = (off >= 0) & (off <= M) & (blk * M - M + jj >= 0)
    s = jnp.where(valid[None, None, :, None, :, :], s, -jnp.inf)
    m = jnp.max(s, axis=-1, keepdims=True)
    p = jnp.exp(s - m)
    l = jnp.sum(p, axis=-1)
    o = jnp.einsum("bdnhij,bdnjhe->bdnihe", p, vb) / jnp.transpose(l, (0, 1, 2, 4, 3))[..., None]
    lse = jnp.transpose(m[..., 0] + jnp.log(l), (0, 1, 2, 4, 3))

    def unstream(a):
        a = a.reshape((B, dil, Lp) + a.shape[4:])[:, :, :L]
        return jnp.swapaxes(a, 1, 2).reshape((B, T) + a.shape[3:])

    return unstream(o), unstream(lse)


def dilated_sample(q, k, v, kbuf, vbuf, dil):
    Bd, S, H, E = q.shape
    M = ATT_STREAM_WIN
    Wb = kbuf.shape[1]
    kc = jnp.concatenate([kbuf, k], axis=1)
    vc = jnp.concatenate([vbuf, v], axis=1)
    idx = Wb + jnp.arange(S)[:, None] - dil * jnp.arange(M + 1)[None, :]
    valid = idx >= 0
    idx = jnp.maximum(idx, 0)
    kg, vg = kc[:, idx], vc[:, idx]
    s = jnp.einsum("bshe,bsmhe->bshm", q, kg) * (E ** -0.5)
    s = jnp.where(valid[None, :, None, :], s, -jnp.inf)
    m = jnp.max(s, axis=-1, keepdims=True)
    p = jnp.exp(s - m)
    l = jnp.sum(p, axis=-1)
    o = jnp.einsum("bshm,bsmhe->bshe", p, vg) / l[..., None]
    return o, m[..., 0] + jnp.log(l)


def token_mixer(xn, pos, ret_s0, kv_bufs, w_in, ret_gn_g, w_pa, w_pb, w_o):
    B, T, _ = xn.shape
    f32 = jnp.float32
    proj = xn @ w_in
    q_r, k_r, v_r, g_r, q_a, k_a, v_a, gate_a, gate_b = jnp.split(proj, IN_SPLIT_IDX, axis=-1)
    qr = rotary(q_r.reshape(B, T, RET_HEADS, RET_DK).astype(f32), pos)
    kr = rotary(k_r.reshape(B, T, RET_HEADS, RET_DK).astype(f32), pos) * (RET_DK ** -0.5)
    vr = v_r.reshape(B, T, RET_HEADS, RET_DV).astype(f32)
    s0 = jnp.zeros((B, RET_HEADS, RET_DK, RET_DV), f32) if ret_s0 is None else ret_s0.astype(f32)
    chunk = T if T <= RET_CHUNK else math.gcd(T, RET_CHUNK)
    o_r, s_new = retention(qr, kr, vr, s0, chunk)
    o_r = o_r * lax.rsqrt(jnp.mean(o_r * o_r, axis=-1, keepdims=True) + EPS)
    o_r = o_r.reshape(B, T, RET_V) * ret_gn_g.astype(f32) * jax.nn.silu(g_r.astype(f32))
    branch_a = o_r.astype(xn.dtype) @ w_pa
    qa = q_a.reshape(B, T, ATT_HEADS, ATT_HD)
    ka = k_a.reshape(B, T, ATT_HEADS, ATT_HD)
    va = v_a.reshape(B, T, ATT_HEADS, ATT_HD)
    outs, lses, new_kv = [], [], []
    for gi, (win, dil) in enumerate(ATT_GROUPS):
        hs = slice(gi * ATT_HPG, (gi + 1) * ATT_HPG)
        qg, kg, vg = qa[:, :, hs], ka[:, :, hs], va[:, :, hs]
        kv_rows = jnp.stack([kg, vg], axis=2)
        if kv_bufs is None:
            o, lse = dilated_prompt(qg.astype(f32), kg.astype(f32), vg.astype(f32), dil)
            new_kv.append(kv_rows[:, T - min(win, T):])
        else:
            buf = kv_bufs[gi].astype(f32)
            o, lse = dilated_sample(qg.astype(f32), kg.astype(f32), vg.astype(f32),
                                    buf[:, :, 0], buf[:, :, 1], dil)
            new_kv.append(kv_rows)
        outs.append(o)
        lses.append(lse)
    alpha = jax.nn.softmax(jnp.stack(lses, axis=0), axis=0)[..., None]
    o_a = jnp.sum(alpha * jnp.stack(outs, axis=0), axis=0).reshape(B, T, ATT_OUT)
    branch_b = o_a.astype(xn.dtype) @ w_pb
    merged = jax.nn.sigmoid(gate_a) * branch_a + jax.nn.sigmoid(gate_b) * branch_b
    return merged @ w_o, s_new, new_kv


def swiglu(xn, w_ffn_in, w_ffn_out):
    a, b = jnp.split(xn @ w_ffn_in, 2, axis=-1)
    return (jax.nn.silu(a) * b) @ w_ffn_out


def run_trunk(x, pos, ret_states, kv_caches, ln1_g, w_in, ret_gn_g, w_pa, w_pb, w_o,
              ln2_g, w_ffn_in, w_ffn_out, lnf_g):
    h = x
    new_s = []
    new_kv = [[] for _ in range(N_GROUPS)]
    for layer in range(DEPTH):
        s0 = None if ret_states is None else ret_states[layer]
        bufs = None if kv_caches is None else [c[layer] for c in kv_caches]
        mix, s_new, kvs = token_mixer(rmsnorm(h, ln1_g[layer]), pos, s0, bufs, w_in[layer],
                                      ret_gn_g[layer], w_pa[layer], w_pb[layer], w_o[layer])
        h = h + mix
        h = h + swiglu(rmsnorm(h, ln2_g[layer]), w_ffn_in[layer], w_ffn_out[layer])
        new_s.append(s_new.astype(x.dtype))
        for gi in range(N_GROUPS):
            new_kv[gi].append(kvs[gi])
    y = rmsnorm(h, lnf_g)
    return y, jnp.stack(new_s, axis=0), [jnp.stack(a, axis=0) for a in new_kv]


def setup_inputs(seed: int = 0) -> dict:
    key = jax.random.key(seed)
    ks = jax.random.split(key, 16)
    nrm = jax.random.normal
    f32 = jnp.float32
    return {
        "x_prompt": nrm(ks[0], (BATCH, SEQ, D_MODEL), f32),
        "x_sample": nrm(ks[1], (DEC_BATCH, DEC_SEQ, D_MODEL), f32),
        "state_ret": 0.1 * nrm(ks[2], (DEPTH, DEC_BATCH, RET_HEADS, RET_DK, RET_DV), f32),
        "cache_kv_w128": nrm(ks[3], (DEPTH, DEC_BATCH, min(ATT_GROUPS[0][0], PAST_LEN), 2, ATT_HPG, ATT_HD), f32),
        "cache_kv_w512": nrm(ks[4], (DEPTH, DEC_BATCH, min(ATT_GROUPS[1][0], PAST_LEN), 2, ATT_HPG, ATT_HD), f32),
        "cache_kv_w2048": nrm(ks[5], (DEPTH, DEC_BATCH, min(ATT_GROUPS[2][0], PAST_LEN), 2, ATT_HPG, ATT_HD), f32),
        "ln1_g": 1.0 + 0.02 * nrm(ks[6], (DEPTH, D_MODEL), f32),
        "w_in": nrm(ks[7], (DEPTH, D_MODEL, IN_TOTAL), f32) * D_MODEL ** -0.5,
        "ret_gn_g": 1.0 + 0.02 * nrm(ks[8], (DEPTH, RET_V), f32),
        "w_pa": nrm(ks[9], (DEPTH, RET_V, D_MODEL), f32) * RET_V ** -0.5,
        "w_pb": nrm(ks[10], (DEPTH, ATT_OUT, D_MODEL), f32) * ATT_OUT ** -0.5,
        "w_o": nrm(ks[11], (DEPTH, D_MODEL, D_MODEL), f32) * D_MODEL ** -0.5,
        "ln2_g": 1.0 + 0.02 * nrm(ks[12], (DEPTH, D_MODEL), f32),
        "w_ffn_in": nrm(ks[13], (DEPTH, D_MODEL, 2 * FFN_HIDDEN), f32) * D_MODEL ** -0.5,
        "w_ffn_out": nrm(ks[14], (DEPTH, FFN_HIDDEN, D_MODEL), f32) * FFN_HIDDEN ** -0.5,
        "lnf_g": 1.0 + 0.02 * nrm(ks[15], (D_MODEL,), f32),
    }


def reference(x_prompt, x_sample, state_ret, cache_kv_w128, cache_kv_w512, cache_kv_w2048,
              ln1_g, w_in, ret_gn_g, w_pa, w_pb, w_o, ln2_g, w_ffn_in, w_ffn_out, lnf_g):
    pos_p = jnp.arange(x_prompt.shape[1], dtype=jnp.int32)
    pos_s = PAST_LEN + jnp.arange(x_sample.shape[1], dtype=jnp.int32)
    y_prompt, s_p, kv_p = run_trunk(x_prompt, pos_p, None, None, ln1_g, w_in, ret_gn_g, w_pa, w_pb,
                                    w_o, ln2_g, w_ffn_in, w_ffn_out, lnf_g)
    y_sample, s_s, kv_s = run_trunk(x_sample, pos_s, state_ret,
                                    [cache_kv_w128, cache_kv_w512, cache_kv_w2048],
                                    ln1_g, w_in, ret_gn_g, w_pa, w_pb, w_o, ln2_g,
                                    w_ffn_in, w_ffn_out, lnf_g)
    return (y_prompt, y_sample, s_p, s_s, kv_p[0], kv_s[0], kv_p[1], kv_s[1], kv_p[2], kv_s[2])
```

```cpp
#include <hip/hip_runtime.h>
#include <hip/hip_cooperative_groups.h>
#include <cstdio>
#include <cstdint>
namespace cg = cooperative_groups;

#ifndef MK_FUSED
#define MK_FUSED 1
#endif

#define LAS __attribute__((address_space(3)))
typedef unsigned short bf16_t;
typedef short bf16x8 __attribute__((ext_vector_type(8)));
typedef short s16x4 __attribute__((ext_vector_type(4)));
typedef float f32x4 __attribute__((ext_vector_type(4)));
typedef float f32x2 __attribute__((ext_vector_type(2)));
typedef unsigned u32x4 __attribute__((ext_vector_type(4)));
typedef unsigned u32x2 __attribute__((ext_vector_type(2)));

constexpr int DM = 1024, SEQ = 4096, NBATCH = 4, TP = NBATCH * SEQ  , NSAMP = 32, MR = TP + NSAMP  , MP = 16640  ;
constexpr int NIN = 12800, RV = 2048, AW = 1536, AOUT = 512, FH = 2816;
constexpr int PAST = 16384;
constexpr float EPS = 1e-6f;
constexpr size_t O_Y = 0, O_SP = 16809984, O_SS = 18907136, O_KV0P = 35684352, O_KV0S = 36208640, O_KV1P = 36241408, O_KV1S = 38338560, O_KV2P = 38371328, O_KV2S = 46759936, O_END = 46792704;
__device__ __forceinline__ float lg2_gamma(int h) { return h == 0 ? -0.04580368961312479f : h == 1 ? -0.02272007650008353f : h == 2 ? -0.011315313227834146f : -0.005646563141142063f; }
constexpr float QSCALE_A = 0.12751743082459868f;
constexpr float LN2 = 0.6931471805599453f;

constexpr size_t MiB = 1u << 20;
constexpr size_t al(size_t x) { return (x + MiB - 1) / MiB * MiB; }
constexpr size_t WS_CTL = 0, CTL_BYTES = MiB;
constexpr size_t WS_ROPEC = WS_CTL + CTL_BYTES, ROPE_BYTES = al((size_t)4097 * 128 * 4);
constexpr size_t WS_ROPES = WS_ROPEC + ROPE_BYTES;
constexpr size_t WS_WIN = WS_ROPES + ROPE_BYTES;
constexpr size_t WS_WPA = WS_WIN + al((size_t)NIN * DM * 2);
constexpr size_t WS_WPB = WS_WPA + al((size_t)DM * RV * 2);
constexpr size_t WS_WO = WS_WPB + al((size_t)DM * AOUT * 2);
constexpr size_t WS_WFI = WS_WO + al((size_t)DM * DM * 2);
constexpr size_t WS_WFO = WS_WFI + al((size_t)2 * FH * DM * 2);
constexpr size_t WS_XN = WS_WFO + al((size_t)DM * FH * 2);
constexpr size_t WS_QR = WS_XN + al((size_t)MP * DM * 2);
constexpr size_t WS_KR = WS_QR + (size_t)MP * DM * 2;
constexpr size_t WS_VR = WS_KR + al((size_t)MP * DM * 2);
constexpr size_t WS_GS = WS_VR + al((size_t)MP * RV * 2);
constexpr size_t WS_QA = WS_GS + al((size_t)MP * RV * 2);
constexpr size_t WS_KA = WS_QA + al((size_t)MP * AW * 2);
constexpr size_t WS_VA = WS_KA + al((size_t)MP * AW * 2);
constexpr size_t WS_SGA = WS_VA + al((size_t)MP * AW * 2);
constexpr size_t WS_SGB = WS_SGA + al((size_t)MP * DM * 2);
constexpr size_t WS_ST = WS_SGB + al((size_t)MP * DM * 2);
constexpr size_t WS_OG = WS_ST + al((size_t)16 * 31 * 512 * 256 * 2);
constexpr size_t WS_LSE = WS_OG + al((size_t)MP * AW * 2);
constexpr size_t WS_APA = WS_LSE + al((size_t)MP * 12 * 4);
constexpr size_t WS_OA = WS_APA + al((size_t)MP * RV * 2);
constexpr size_t WS_RSS1 = WS_OA + al((size_t)MP * AOUT * 2);
constexpr size_t WS_RSS2 = WS_RSS1 + al((size_t)MP * 16 * 4);
constexpr size_t WS_OS = WS_RSS2 + al((size_t)MP * 16 * 4);
constexpr size_t WS_END = WS_OS + MiB;
constexpr size_t WS_MERGED = WS_XN, WS_P = WS_QR, WS_H = WS_VR, WS_HB = WS_SGA, WS_HID = WS_ST;
static_assert((size_t)MP * FH * 2 <= (size_t)16 * 31 * 512 * 256 * 2, "HID overlays ST");
static_assert(WS_KR + (size_t)MP * DM * 2 - WS_QR >= (size_t)MP * DM * 4, "P overlays QR|KR");
static_assert(WS_END <= (size_t)1024 * MiB, "workspace map");
constexpr int CW_Q2 = 64, CW_Q3 = 128;

constexpr int LDS_BYTES = 147456, LDS_MISC = 143360;

__device__ __forceinline__ unsigned cvt_pk_bf16(float lo, float hi) { unsigned r; asm volatile("v_cvt_pk_bf16_f32 %0, %1, %2" : "=v"(r) : "v"(lo), "v"(hi)); return r; }
__device__ __forceinline__ float bf2f(unsigned short b) { return __uint_as_float((unsigned)b << 16); }
__device__ __forceinline__ float bflo(unsigned w) { return __uint_as_float(w << 16); }
__device__ __forceinline__ float bfhi(unsigned w) { return __uint_as_float(w & 0xffff0000u); }
__device__ __forceinline__ float fexp2(float x) { return __builtin_amdgcn_exp2f(x); }
__device__ __forceinline__ float flog2(float x) { return __builtin_amdgcn_logf(x); }
__device__ __forceinline__ float frcp(float x) { return __builtin_amdgcn_rcpf(x); }
__device__ __forceinline__ float sigmoidf_(float x) { return frcp(1.0f + fexp2(-1.4426950408889634f * x)); }
__device__ __forceinline__ float siluf_(float x) { return x * sigmoidf_(x); }
__device__ __forceinline__ int opaque(int x) { asm volatile("" : "+v"(x)); return x; }
__device__ __forceinline__ float wave_sum(float v) {
#pragma unroll
    for (int o = 1; o < 64; o <<= 1) v += __shfl_xor(v, o);
    return v;
}
__device__ __forceinline__ s16x4 tr16(const LAS unsigned char* p) {
    typedef short v4i16_t __attribute__((ext_vector_type(4)));
    return __builtin_bit_cast(s16x4, __builtin_amdgcn_ds_read_tr16_b64_v4i16((LAS v4i16_t*)p));
}
__device__ __forceinline__ bf16x8 cat8(s16x4 a, s16x4 b) { bf16x8 r; r[0] = a[0]; r[1] = a[1]; r[2] = a[2]; r[3] = a[3]; r[4] = b[0]; r[5] = b[1]; r[6] = b[2]; r[7] = b[3]; return r; }
__device__ __forceinline__ f32x4 mfma16(bf16x8 a, bf16x8 b, f32x4 c) { return __builtin_amdgcn_mfma_f32_16x16x32_bf16(a, b, c, 0, 0, 0); }

namespace pg8 {
constexpr int BM = 256, BK = 64, HALF = 128, HTB = HALF * BK * 2, STAGE_BYTES = 8 * HTB, NXCD = 8, WGM = 8;
__host__ __device__ __forceinline__ int lds_byte(int r, int c) { const int st = (r >> 4) * 2 + (c >> 5), rr = r & 15, cc = c & 31, ob = rr * 64 + cc * 2; return st * 1024 + (ob ^ (((ob >> 9) & 1) << 5)); }
__host__ __device__ __forceinline__ void stage_rc(int b, int& R, int& C) { const int st = b / 1024, sb = b % 1024, swz = sb ^ (((sb >> 9) & 1) << 5); R = (st >> 1) * 16 + swz / 64; C = (st & 1) * 32 + (swz % 64) / 2; }
__host__ __device__ __forceinline__ int perm32(int rho) { const int n = rho >> 4, i = rho & 15; return 8 * (i >> 2) + 4 * n + (i & 3); }
struct Unit { int pm, pn; };
struct Gemm { const bf16_t* A; const bf16_t* Bt; int M, N, K; };
struct StaticOrder {
    int nM, nN, nwg, G, c;
    __host__ __device__ void init(int M, int N, int G_, int c_) { nM = M / BM; nN = N / BM; nwg = nM * nN; G = G_; c = c_; }
    __host__ __device__ bool next(int i, Unit& u) const {
        const long L = (long)i * G + c; if (L >= nwg) return false;
        int wgid = (int)L; { const int q = nwg / NXCD, r = nwg % NXCD, xcd = wgid % NXCD, off = wgid / NXCD; wgid = (xcd < r ? xcd * (q + 1) : r * (q + 1) + (xcd - r) * q) + off; }
        const int nig = WGM * nN, gid = wgid / nig, fm = gid * WGM, gsz = (nM - fm) < WGM ? (nM - fm) : WGM;
        u.pm = fm + ((wgid % nig) % gsz); u.pn = (wgid % nig) / gsz; return true;
    }
    __device__ __forceinline__ void a_ready(const Unit&) const {}
    __device__ __forceinline__ void done(const Unit&) const {}
};
template <class Epi, class Sched, bool ALIGN_EPI = false, bool SP2 = false>
__device__ __forceinline__ void gemm_phase(LAS unsigned char* lds, const Gemm g, const Sched& S, const Epi& E) {
    int tid_ = threadIdx.x; asm volatile("" : "+v"(tid_));
    const int tid = tid_, wid = __builtin_amdgcn_readfirstlane(tid >> 6), lane = tid & 63, wr = wid >> 2, wc = wid & 3, fr = lane & 15, fq = lane >> 4;
    const int K = g.K, nt = K / BK;
    unsigned voffA[2], voffB[2];
#pragma unroll
    for (int i = 0; i < 2; ++i) { int R, C; stage_rc(tid * 16 + i * 8192, R, C); const int Rb = Epi::PERM ? ((R & ~31) + perm32(R & 31)) : R;
        voffA[i] = (unsigned)(R * K + C) * 2u; voffB[i] = (unsigned)(Rb * K + C) * 2u; }
    const size_t kstep = (size_t)(BK * 2);
    const size_t hstep = (size_t)HALF * K * 2;
    const size_t tstep = 2 * hstep;
    const unsigned ldsw = (unsigned)wid * 1024u;
    const int aoff = lds_byte(wr * 64 + fr, fq * 8), boff = lds_byte(wc * 32 + fr, fq * 8);
#define PG8_SA(b, h) (((b) * 2 + (h)) * HTB)
#define PG8_SB(b, h) ((4 + (b) * 2 + (h)) * HTB)
#define PG8_STAGE(bufoff, gbase, voff) do { _Pragma("unroll") for (int _i = 0; _i < 2; ++_i) \
        __builtin_amdgcn_global_load_lds((const unsigned*)((const char*)(gbase) + (voff)[_i]), (LAS unsigned*)(lds + (bufoff) + ldsw + _i * 8192), 16, 0, 0); } while (0)
#define PG8_LDA(dst, b, h) do { _Pragma("unroll") for (int m = 0; m < 4; ++m) _Pragma("unroll") for (int k = 0; k < 2; ++k) dst[m][k] = *(const LAS bf16x8*)(lds + PG8_SA(b, h) + aoff + m * 2048 + k * 1024); } while (0)
#define PG8_LDB(dst, b, h) do { _Pragma("unroll") for (int n = 0; n < 2; ++n) _Pragma("unroll") for (int k = 0; k < 2; ++k) dst[n][k] = *(const LAS bf16x8*)(lds + PG8_SB(b, h) + boff + n * 2048 + k * 1024); } while (0)
#define PG8_MMA(ai, bj, At, Bt) do { __builtin_amdgcn_s_setprio(1); _Pragma("unroll") for (int m = 0; m < 4; ++m) _Pragma("unroll") for (int n = 0; n < 2; ++n) _Pragma("unroll") for (int k = 0; k < 2; ++k) \
        acc[ai][bj][m][n] = __builtin_amdgcn_mfma_f32_16x16x32_bf16(Bt[n][k], At[m][k], acc[ai][bj][m][n], 0, 0, 0); __builtin_amdgcn_s_setprio(0); } while (0)
#define PG8_WAIT_V(n) asm volatile("s_waitcnt vmcnt(" #n ")" ::: "memory")
#define PG8_WAIT_L(n) asm volatile("s_waitcnt lgkmcnt(" #n ")" ::: "memory")
#define PG8_BAR __builtin_amdgcn_s_barrier()
#define PG8_SCHED __builtin_amdgcn_sched_barrier(0)
    Unit cur, nxt; int ui = 0;
    if (!S.next(0, cur)) return;
    f32x4 acc[2][2][4][2];
#pragma unroll
    for (int a = 0; a < 2; ++a)
#pragma unroll
        for (int b = 0; b < 2; ++b)
#pragma unroll
            for (int m = 0; m < 4; ++m)
#pragma unroll
                for (int n = 0; n < 2; ++n) acc[a][b][m][n] = (f32x4){0.f, 0.f, 0.f, 0.f};
    bf16x8 At[4][2], B0[2][2], B1[2][2];
    const char* cA = (const char*)g.A + (size_t)cur.pm * tstep; const char* cB = (const char*)g.Bt + (size_t)cur.pn * tstep;
    S.a_ready(cur);
    if constexpr (SP2) {
        PG8_STAGE(PG8_SB(0, 0), cB, voffB); PG8_STAGE(PG8_SB(0, 1), cB + hstep, voffB); PG8_STAGE(PG8_SA(0, 0), cA, voffA); PG8_STAGE(PG8_SA(0, 1), cA + hstep, voffA);
        if (wr == 1) PG8_BAR;
        PG8_WAIT_V(2); PG8_BAR;
        PG8_STAGE(PG8_SB(1, 0), cB + kstep, voffB); PG8_STAGE(PG8_SA(1, 0), cA + kstep, voffA); PG8_STAGE(PG8_SB(1, 1), cB + hstep + kstep, voffB);
        PG8_WAIT_V(6); PG8_BAR;
    } else {
        PG8_STAGE(PG8_SB(0, 0), cB, voffB); PG8_STAGE(PG8_SA(0, 0), cA, voffA); PG8_STAGE(PG8_SB(0, 1), cB + hstep, voffB); PG8_STAGE(PG8_SA(0, 1), cA + hstep, voffA);
        if (wr == 1) PG8_BAR;
        PG8_WAIT_V(4); PG8_BAR;
        PG8_STAGE(PG8_SB(1, 0), cB + kstep, voffB); PG8_STAGE(PG8_SA(1, 0), cA + kstep, voffA); PG8_STAGE(PG8_SB(1, 1), cB + hstep + kstep, voffB);
        PG8_WAIT_V(6); PG8_BAR;
    }
    for (;;) {
        const bool has_next = S.next(ui + 1, nxt);
        const char* nA = has_next ? (const char*)g.A + (size_t)nxt.pm * tstep : cA; const char* nB = has_next ? (const char*)g.Bt + (size_t)nxt.pn * tstep : cB;
        for (int t = 0; t < nt; t += 2) {
            const bool last = (t == nt - 2);
            const char* a1 = cA + (size_t)(t + 1) * kstep;
            const char* a2 = last ? nA : cA + (size_t)(t + 2) * kstep; const char* b2 = last ? nB : cB + (size_t)(t + 2) * kstep;
            const char* a3 = a2 + kstep; const char* b3 = b2 + kstep;
            if (last && has_next) S.a_ready(nxt);
            if constexpr (SP2) {
            PG8_LDB(B0, 0, 0); PG8_LDB(B1, 0, 1); PG8_SCHED; PG8_LDA(At, 0, 0); PG8_STAGE(PG8_SA(1, 1), a1 + hstep, voffA);
            PG8_WAIT_V(8); PG8_WAIT_L(0); PG8_BAR; PG8_MMA(0, 0, At, B0); PG8_MMA(0, 1, At, B1); PG8_BAR; PG8_SCHED;
            PG8_LDA(At, 0, 1); PG8_STAGE(PG8_SB(0, 0), b2, voffB); PG8_STAGE(PG8_SB(0, 1), b2 + hstep, voffB); PG8_STAGE(PG8_SA(0, 0), a2, voffA);
            PG8_WAIT_V(8); PG8_WAIT_L(0); PG8_BAR; PG8_MMA(1, 0, At, B0); PG8_MMA(1, 1, At, B1); PG8_BAR; PG8_SCHED;
            PG8_LDB(B0, 1, 0); PG8_LDB(B1, 1, 1); PG8_SCHED; PG8_LDA(At, 1, 0); PG8_STAGE(PG8_SA(0, 1), a2 + hstep, voffA);
            PG8_WAIT_V(8); PG8_WAIT_L(0); PG8_BAR; PG8_MMA(0, 0, At, B0); PG8_MMA(0, 1, At, B1); PG8_BAR; PG8_SCHED;
            PG8_LDA(At, 1, 1); PG8_STAGE(PG8_SB(1, 0), b3, voffB); PG8_STAGE(PG8_SB(1, 1), b3 + hstep, voffB); PG8_STAGE(PG8_SA(1, 0), a3, voffA);
            PG8_WAIT_V(8); PG8_WAIT_L(0); PG8_BAR; PG8_MMA(1, 0, At, B0); PG8_MMA(1, 1, At, B1); PG8_BAR; PG8_SCHED;
            } else {
            PG8_LDB(B0, 0, 0); PG8_SCHED; PG8_LDA(At, 0, 0); PG8_STAGE(PG8_SA(1, 1), a1 + hstep, voffA);
            PG8_WAIT_L(8); PG8_BAR; PG8_WAIT_L(0); PG8_MMA(0, 0, At, B0); PG8_BAR; PG8_SCHED;
            PG8_LDB(B1, 0, 1); PG8_STAGE(PG8_SB(0, 0), b2, voffB);
            PG8_BAR; PG8_WAIT_L(0); PG8_MMA(0, 1, At, B1); PG8_BAR;
            PG8_LDA(At, 0, 1); PG8_STAGE(PG8_SA(0, 0), a2, voffA);
            PG8_BAR; PG8_WAIT_L(0); PG8_MMA(1, 0, At, B0); PG8_BAR; PG8_SCHED;
            PG8_STAGE(PG8_SB(0, 1), b2 + hstep, voffB);
            PG8_WAIT_V(6); PG8_BAR; PG8_MMA(1, 1, At, B1); PG8_BAR;
            PG8_LDB(B0, 1, 0); PG8_SCHED; PG8_LDA(At, 1, 0); PG8_STAGE(PG8_SA(0, 1), a2 + hstep, voffA);
            PG8_WAIT_L(8); PG8_BAR; PG8_WAIT_L(0); PG8_MMA(0, 0, At, B0); PG8_BAR; PG8_SCHED;
            PG8_LDB(B1, 1, 1); PG8_STAGE(PG8_SB(1, 0), b3, voffB);
            PG8_BAR; PG8_WAIT_L(0); PG8_MMA(0, 1, At, B1); PG8_BAR;
            PG8_LDA(At, 1, 1); PG8_STAGE(PG8_SA(1, 0), a3, voffA);
            PG8_BAR; PG8_WAIT_L(0); PG8_MMA(1, 0, At, B0); PG8_BAR; PG8_SCHED;
            PG8_STAGE(PG8_SB(1, 1), b3 + hstep, voffB);
            PG8_WAIT_V(6); PG8_BAR; PG8_MMA(1, 1, At, B1); PG8_BAR;
            }
        }
        if constexpr (ALIGN_EPI) { if (wr == 0) PG8_BAR; }
        if constexpr (!Epi::AFTER_DRAIN) { E(acc, cur, wr, wc, fr, fq); S.done(cur); }
        if (!has_next) break;
#pragma unroll
        for (int a = 0; a < 2; ++a)
#pragma unroll
            for (int b = 0; b < 2; ++b)
#pragma unroll
                for (int m = 0; m < 4; ++m)
#pragma unroll
                    for (int n = 0; n < 2; ++n) acc[a][b][m][n] = (f32x4){0.f, 0.f, 0.f, 0.f};
        cur = nxt; cA = nA; cB = nB; ++ui;
        if constexpr (ALIGN_EPI) { if (wr == 1) PG8_BAR; }
    }
    PG8_WAIT_V(0);
    if constexpr (!ALIGN_EPI) { if (wr == 0) PG8_BAR; }
    PG8_BAR;
#undef PG8_SA
#undef PG8_SB
#undef PG8_STAGE
#undef PG8_LDA
#undef PG8_LDB
#undef PG8_MMA
#undef PG8_WAIT_V
#undef PG8_WAIT_L
#undef PG8_BAR
#undef PG8_SCHED
}
}
using pg8::Unit;

__device__ __forceinline__ u32x4 pack8(f32x4 a, f32x4 b) { u32x4 w; w.x = cvt_pk_bf16(a[0], a[1]); w.y = cvt_pk_bf16(a[2], a[3]); w.z = cvt_pk_bf16(b[0], b[1]); w.w = cvt_pk_bf16(b[2], b[3]); return w; }
__device__ __forceinline__ void unpack8(u32x4 w, f32x4& a, f32x4& b) { a[0] = bflo(w.x); a[1] = bfhi(w.x); a[2] = bflo(w.y); a[3] = bfhi(w.y); b[0] = bflo(w.z); b[1] = bfhi(w.z); b[2] = bflo(w.w); b[3] = bfhi(w.w); }

struct EpiIn {
    static constexpr bool PERM = true, AFTER_DRAIN = false;
    unsigned char* ws; const float *ropec, *ropes; float* out;
    __device__ __forceinline__ void operator()(const f32x4 (&acc)[2][2][4][2], const Unit& u, int wr, int wc, int fr, int fq) const {
        const int pn = u.pn, rbase = u.pm * 256 + wr * 64 + fr, cb = wc * 32 + 8 * fq;
        if (pn < 8) {
            const int h = pn & 3; const bool isq = pn < 4; bf16_t* dst = (bf16_t*)(ws + (isq ? WS_QR : WS_KR)); const float lg = lg2_gamma(h);
#pragma unroll
            for (int ai = 0; ai < 2; ++ai)
#pragma unroll
                for (int m = 0; m < 4; ++m) {
                    const int row = rbase + ai * 128 + m * 16; const int pidx = row < TP ? (row & (SEQ - 1)) : 4096;
                    float sc;
                    if (row < TP) { const int tt = row & 127; sc = isq ? fexp2((float)(tt + 1) * lg) : 0.0625f * fexp2((float)(127 - tt) * lg); } else sc = isq ? 1.0f : 0.0625f;
                    f32x4 o1[2], o2[2];
#pragma unroll
                    for (int n = 0; n < 2; ++n) {
                        const f32x4 c = *(const f32x4*)(ropec + (size_t)pidx * 128 + cb + 4 * n), s = *(const f32x4*)(ropes + (size_t)pidx * 128 + cb + 4 * n);
                        const f32x4 x1 = acc[ai][0][m][n], x2 = acc[ai][1][m][n];
                        o1[n] = (x1 * c - x2 * s) * sc; o2[n] = (x1 * s + x2 * c) * sc;
                    }
                    bf16_t* p = dst + (size_t)row * DM + h * 256 + cb;
                    *(u32x4*)p = pack8(o1[0], o1[1]); *(u32x4*)(p + 128) = pack8(o2[0], o2[1]);
                }
            return;
        }
        size_t doff; int ld, col0; int mode = 0; float scl = 1.0f;
        if (pn < 16) { doff = WS_VR; ld = RV; col0 = (pn - 8) * 256; }
        else if (pn < 24) { doff = WS_GS; ld = RV; col0 = (pn - 16) * 256; mode = 1; }
        else if (pn < 30) { doff = WS_QA; ld = AW; col0 = (pn - 24) * 256; scl = QSCALE_A; }
        else if (pn < 36) { doff = WS_KA; ld = AW; col0 = (pn - 30) * 256; }
        else if (pn < 42) { doff = WS_VA; ld = AW; col0 = (pn - 36) * 256; }
        else if (pn < 46) { doff = WS_SGA; ld = DM; col0 = (pn - 42) * 256; mode = 2; }
        else { doff = WS_SGB; ld = DM; col0 = (pn - 46) * 256; mode = 2; }
        bf16_t* dst = (bf16_t*)(ws + doff);
        const bool iskv = pn >= 30 && pn < 42;
        int kvsel = 0, grp = 0, half = 0, win = 0; size_t obp = 0, obs = 0;
        if (iskv) { const int idx = pn >= 36 ? pn - 36 : pn - 30; kvsel = pn >= 36 ? 1 : 0; grp = idx >> 1; half = idx & 1; win = 128 << (2 * grp);
            obp = grp == 0 ? O_KV0P : grp == 1 ? O_KV1P : O_KV2P; obs = grp == 0 ? O_KV0S : grp == 1 ? O_KV1S : O_KV2S; }
#pragma unroll
        for (int ai = 0; ai < 2; ++ai)
#pragma unroll
            for (int m = 0; m < 4; ++m) {
                const int row = rbase + ai * 128 + m * 16;
#pragma unroll
                for (int bj = 0; bj < 2; ++bj) {
                    f32x4 v0 = acc[ai][bj][m][0], v1 = acc[ai][bj][m][1];
                    if (iskv) {
                        float* op = nullptr;
                        if (row < TP) { const int t = row & (SEQ - 1), b = row >> 12; if (t >= SEQ - win) op = out + obp + ((size_t)(b * win + (t - (SEQ - win))) * 2 + kvsel) * 512 + half * 256 + bj * 128 + cb; }
                        else if (row < MR) op = out + obs + ((size_t)(row - TP) * 2 + kvsel) * 512 + half * 256 + bj * 128 + cb;
                        if (op) { *(f32x4*)op = v0; *(f32x4*)(op + 4) = v1; }
                    }
                    if (mode == 1) {
#pragma unroll
                        for (int i = 0; i < 4; ++i) { v0[i] = siluf_(v0[i]); v1[i] = siluf_(v1[i]); }
                    } else if (mode == 2) {
#pragma unroll
                        for (int i = 0; i < 4; ++i) { v0[i] = sigmoidf_(v0[i]); v1[i] = sigmoidf_(v1[i]); }
                    } else { v0 = v0 * scl; v1 = v1 * scl; }
                    *(u32x4*)(dst + (size_t)row * ld + col0 + bj * 128 + cb) = pack8(v0, v1);
                }
            }
    }
};

struct EpiPa {
    static constexpr bool PERM = true, AFTER_DRAIN = false;
    const bf16_t* SGA; float* P;
    __device__ __forceinline__ void operator()(const f32x4 (&acc)[2][2][4][2], const Unit& u, int wr, int wc, int fr, int fq) const {
        const int rbase = u.pm * 256 + wr * 64 + fr, cb = u.pn * 256 + wc * 32 + 8 * fq;
#pragma unroll
        for (int ai = 0; ai < 2; ++ai)
#pragma unroll
            for (int m = 0; m < 4; ++m) { const size_t ro = (size_t)(rbase + ai * 128 + m * 16) * DM + cb;
#pragma unroll
                for (int bj = 0; bj < 2; ++bj) { f32x4 g0, g1; unpack8(*(const u32x4*)(SGA + ro + bj * 128), g0, g1);
                    *(f32x4*)(P + ro + bj * 128) = acc[ai][bj][m][0] * g0; *(f32x4*)(P + ro + bj * 128 + 4) = acc[ai][bj][m][1] * g1; } }
    }
};
struct EpiPb {
    static constexpr bool PERM = true, AFTER_DRAIN = false;
    const bf16_t* SGB; const float* P; bf16_t* MG;
    __device__ __forceinline__ void operator()(const f32x4 (&acc)[2][2][4][2], const Unit& u, int wr, int wc, int fr, int fq) const {
        const int rbase = u.pm * 256 + wr * 64 + fr, cb = u.pn * 256 + wc * 32 + 8 * fq;
#pragma unroll
        for (int ai = 0; ai < 2; ++ai)
#pragma unroll
            for (int m = 0; m < 4; ++m) { const size_t ro = (size_t)(rbase + ai * 128 + m * 16) * DM + cb;
#pragma unroll
                for (int bj = 0; bj < 2; ++bj) { f32x4 g0, g1; unpack8(*(const u32x4*)(SGB + ro + bj * 128), g0, g1);
                    const f32x4 p0 = *(const f32x4*)(P + ro + bj * 128), p1 = *(const f32x4*)(P + ro + bj * 128 + 4);
                    *(u32x4*)(MG + ro + bj * 128) = pack8(p0 + acc[ai][bj][m][0] * g0, p1 + acc[ai][bj][m][1] * g1); } }
    }
};
struct EpiO {
    static constexpr bool PERM = true, AFTER_DRAIN = false;
    const float *xp, *xs; float* H; bf16_t* HB; float* RSS;
    __device__ __forceinline__ void operator()(const f32x4 (&acc)[2][2][4][2], const Unit& u, int wr, int wc, int fr, int fq) const {
        const int rbase = u.pm * 256 + wr * 64 + fr, cb = u.pn * 256 + wc * 32 + 8 * fq;
#pragma unroll
        for (int ai = 0; ai < 2; ++ai)
#pragma unroll
            for (int m = 0; m < 4; ++m) { const int row = rbase + ai * 128 + m * 16; const size_t ro = (size_t)row * DM + cb;
                const float* xr = row < TP ? xp + ro : (row < MR ? xs + (size_t)(row - TP) * DM + cb : nullptr);
                float ss = 0.f;
#pragma unroll
                for (int bj = 0; bj < 2; ++bj) {
                    f32x4 x0 = (f32x4){0.f, 0.f, 0.f, 0.f}, x1 = x0; if (xr) { x0 = *(const f32x4*)(xr + bj * 128); x1 = *(const f32x4*)(xr + bj * 128 + 4); }
                    const f32x4 h0 = x0 + acc[ai][bj][m][0], h1 = x1 + acc[ai][bj][m][1];
                    *(f32x4*)(H + ro + bj * 128) = h0; *(f32x4*)(H + ro + bj * 128 + 4) = h1; *(u32x4*)(HB + ro + bj * 128) = pack8(h0, h1);
                    ss += (h0[0] * h0[0] + h0[1] * h0[1]) + (h0[2] * h0[2] + h0[3] * h0[3]) + (h1[0] * h1[0] + h1[1] * h1[1]) + (h1[2] * h1[2] + h1[3] * h1[3]);
                }
                ss += __shfl_xor(ss, 16); ss += __shfl_xor(ss, 32);
                if (fq == 0) RSS[(size_t)row * 16 + u.pn * 4 + wc] = ss;
            }
    }
};
struct EpiFi {
    static constexpr bool PERM = true, AFTER_DRAIN = false;
    const float* RSS; bf16_t* HID;
    __device__ __forceinline__ void operator()(const f32x4 (&acc)[2][2][4][2], const Unit& u, int wr, int wc, int fr, int fq) const {
        const int rbase = u.pm * 256 + wr * 64 + fr, cb = u.pn * 128 + wc * 32 + 8 * fq;
#pragma unroll
        for (int ai = 0; ai < 2; ++ai)
#pragma unroll
            for (int m = 0; m < 4; ++m) { const int row = rbase + ai * 128 + m * 16;
                const f32x4* rp = (const f32x4*)(RSS + (size_t)row * 16); const f32x4 r0 = rp[0], r1 = rp[1], r2 = rp[2], r3 = rp[3];
                const float ssum = ((r0[0] + r0[1]) + (r0[2] + r0[3])) + ((r1[0] + r1[1]) + (r1[2] + r1[3])) + ((r2[0] + r2[1]) + (r2[2] + r2[3])) + ((r3[0] + r3[1]) + (r3[2] + r3[3]));
                const float rinv = rsqrtf(ssum * (1.0f / DM) + EPS);
                f32x4 o[2];
#pragma unroll
                for (int n = 0; n < 2; ++n) { const f32x4 a = acc[ai][0][m][n] * rinv, b = acc[ai][1][m][n] * rinv;
#pragma unroll
                    for (int i = 0; i < 4; ++i) o[n][i] = siluf_(a[i]) * b[i]; }
                *(u32x4*)(HID + (size_t)row * FH + cb) = pack8(o[0], o[1]);
            }
    }
};
struct EpiFo {
    static constexpr bool PERM = true, AFTER_DRAIN = false;
    const float* H; float* Y; float* RSS;
    __device__ __forceinline__ void operator()(const f32x4 (&acc)[2][2][4][2], const Unit& u, int wr, int wc, int fr, int fq) const {
        const int rbase = u.pm * 256 + wr * 64 + fr, cb = u.pn * 256 + wc * 32 + 8 * fq;
#pragma unroll
        for (int ai = 0; ai < 2; ++ai)
#pragma unroll
            for (int m = 0; m < 4; ++m) { const int row = rbase + ai * 128 + m * 16; const size_t ro = (size_t)row * DM + cb;
                float ss = 0.f;
#pragma unroll
                for (int bj = 0; bj < 2; ++bj) {
                    const f32x4 h0 = *(const f32x4*)(H + ro + bj * 128) + acc[ai][bj][m][0], h1 = *(const f32x4*)(H + ro + bj * 128 + 4) + acc[ai][bj][m][1];
                    if (row < MR) { *(f32x4*)(Y + ro + bj * 128) = h0; *(f32x4*)(Y + ro + bj * 128 + 4) = h1; }
                    ss += (h0[0] * h0[0] + h0[1] * h0[1]) + (h0[2] * h0[2] + h0[3] * h0[3]) + (h1[0] * h1[0] + h1[1] * h1[1]) + (h1[2] * h1[2] + h1[3] * h1[3]);
                }
                ss += __shfl_xor(ss, 16); ss += __shfl_xor(ss, 32);
                if (fq == 0) RSS[(size_t)row * 16 + u.pn * 4 + wc] = ss;
            }
    }
};

struct Args {
    const float* in[16]; float* out; unsigned char* ws;
};
struct Ctx {
    LAS unsigned char* lds; int tid, lane, wave, G, bid;
    const __attribute__((address_space(4))) Args* ka;
    float* out; unsigned char* ws;
};
#define WSP(T, off) ((T*)(C.ws + (off)))

template <int MODE>
__device__ __forceinline__ void p0_transpose_item(const float* W, int K, int N, bf16_t* WT, const float* kscale, LAS float* scr, int item, int lane) {
    const int nblk = N / 32, kb = item / nblk, nb = item % nblk, k0 = 64 * kb, n0 = 32 * nb;
#pragma unroll 8
    for (int i = 0; i < 32; ++i) { const int kk = 2 * i + (lane >> 5); float v = W[(size_t)(k0 + kk) * N + n0 + (lane & 31)]; if (kscale) v *= kscale[k0 + kk]; scr[kk * 33 + (lane & 31)] = v; }
    asm volatile("s_waitcnt lgkmcnt(0)" ::: "memory");
    const int c = lane & 7;
#pragma unroll
    for (int j = 0; j < 4; ++j) { const int n = (lane >> 3) + 8 * j; const LAS float* s = scr + (8 * c) * 33 + n;
        u32x4 o; o.x = cvt_pk_bf16(s[0 * 33], s[1 * 33]); o.y = cvt_pk_bf16(s[2 * 33], s[3 * 33]); o.z = cvt_pk_bf16(s[4 * 33], s[5 * 33]); o.w = cvt_pk_bf16(s[6 * 33], s[7 * 33]);
        int nn = n0 + n;
        if (MODE == 1) { nn = nn < FH ? (nn >> 7) * 256 + (nn & 127) : ((nn - FH) >> 7) * 256 + 128 + ((nn - FH) & 127); }
        *(u32x4*)(WT + (size_t)nn * K + k0 + 8 * c) = o; }
    asm volatile("s_waitcnt lgkmcnt(0)" ::: "memory");
}
__device__ __forceinline__ void p0_prep(const Ctx& C) {
    LAS float* scr = (LAS float*)(C.lds + C.wave * 16384);
    const int gw = C.bid * 8 + C.wave, NGW = C.G * 8, lane = C.lane;
    constexpr int I_IN = (DM / 64) * (NIN / 32), I_PA = (RV / 64) * (DM / 32), I_PB = (AOUT / 64) * (DM / 32), I_O = (DM / 64) * (DM / 32), I_FI = (DM / 64) * (2 * FH / 32), I_FO = (FH / 64) * (DM / 32);
    constexpr int NITEMS = I_IN + I_PA + I_PB + I_O + I_FI + I_FO;
    for (int it = gw; it < NITEMS; it += NGW) {
        int r = it;
        if (r < I_IN) { p0_transpose_item<0>(C.ka->in[7], DM, NIN, WSP(bf16_t, WS_WIN), nullptr, scr, r, lane); continue; } r -= I_IN;
        if (r < I_PA) { p0_transpose_item<0>(C.ka->in[9], RV, DM, WSP(bf16_t, WS_WPA), nullptr, scr, r, lane); continue; } r -= I_PA;
        if (r < I_PB) { p0_transpose_item<0>(C.ka->in[10], AOUT, DM, WSP(bf16_t, WS_WPB), nullptr, scr, r, lane); continue; } r -= I_PB;
        if (r < I_O) { p0_transpose_item<0>(C.ka->in[11], DM, DM, WSP(bf16_t, WS_WO), nullptr, scr, r, lane); continue; } r -= I_O;
        if (r < I_FI) { p0_transpose_item<1>(C.ka->in[13], DM, 2 * FH, WSP(bf16_t, WS_WFI), C.ka->in[12], scr, r, lane); continue; } r -= I_FI;
        p0_transpose_item<0>(C.ka->in[14], FH, DM, WSP(bf16_t, WS_WFO), nullptr, scr, r, lane);
    }
    const f32x4* g4 = (const f32x4*)C.ka->in[6];
    bf16_t* XN = WSP(bf16_t, WS_XN);
    for (int row = gw; row < MP; row += NGW) {
        u32x2* o8 = (u32x2*)(XN + (size_t)row * DM) + lane;
        if (row >= MR) {
#pragma unroll
            for (int j = 0; j < 4; ++j) o8[64 * j] = (u32x2){0u, 0u};
            continue; }
        const f32x4* xr = (const f32x4*)(row < TP ? C.ka->in[0] + (size_t)row * DM : C.ka->in[1] + (size_t)(row - TP) * DM) + lane;
        f32x4 v[4]; float s = 0.f;
#pragma unroll
        for (int j = 0; j < 4; ++j) { v[j] = xr[64 * j]; s += (v[j][0] * v[j][0] + v[j][1] * v[j][1]) + (v[j][2] * v[j][2] + v[j][3] * v[j][3]); }
        const float rinv = rsqrtf(wave_sum(s) * (1.0f / DM) + EPS);
#pragma unroll
        for (int j = 0; j < 4; ++j) { const f32x4 g = g4[lane + 64 * j]; const f32x4 y = v[j] * rinv * g; o8[64 * j] = (u32x2){cvt_pk_bf16(y[0], y[1]), cvt_pk_bf16(y[2], y[3])}; }
    }
    float* rc = WSP(float, WS_ROPEC); float* rs = WSP(float, WS_ROPES);
    for (int e = (C.bid * 512 + C.tid); e < 4097 * 128; e += C.G * 512) {
        const int p = e >> 7, j = e & 127; const float pos = p < 4096 ? (float)p : (float)PAST;
        const float inv = exp2f(-(float)j * (13.287712379549449f / 128.0f));
        const float ang = pos * inv;
        double r = (double)ang * 0.15915494309189535; r -= floor(r);
        const float fr = (float)r;
        rc[e] = __builtin_amdgcn_cosf(fr); rs[e] = __builtin_amdgcn_sinf(fr);
    }
    { u32x4* pa = (u32x4*)(WSP(bf16_t, WS_APA) + (size_t)MR * RV); const int n1 = (MP - MR) * RV / 8;
      for (int e = C.bid * 512 + C.tid; e < n1; e += C.G * 512) pa[e] = (u32x4){0u, 0u, 0u, 0u};
      u32x4* oa = (u32x4*)(WSP(bf16_t, WS_OA) + (size_t)MR * AOUT); const int n2 = (MP - MR) * AOUT / 8;
      for (int e = C.bid * 512 + C.tid; e < n2; e += C.G * 512) oa[e] = (u32x4){0u, 0u, 0u, 0u}; }
}

__device__ __forceinline__ int wq_next(const Ctx& C, unsigned* ctr) {
    volatile LAS int* slot = (volatile LAS int*)(C.lds + LDS_MISC);
    __syncthreads();
    if (C.tid == 0) *slot = (int)__hip_atomic_fetch_add(ctr, 1u, __ATOMIC_RELAXED, __HIP_MEMORY_SCOPE_AGENT);
    __syncthreads();
    return *slot;
}

__device__ __forceinline__ void ret_chain_task(const Ctx& C, int task) {
    const int bh = task >> 3, sl = task & 7, b = bh >> 2, h = bh & 3, lane = opaque(C.lane), w = C.wave, g = lane >> 4, q4 = (lane & 15) >> 2, p4 = lane & 3;
    const bf16_t* KR = WSP(const bf16_t, WS_KR) + h * 256; const bf16_t* VR = WSP(const bf16_t, WS_VR) + h * 512 + sl * 64;
    bf16_t* ST = WSP(bf16_t, WS_ST);
    LAS unsigned char* KT = C.lds; LAS unsigned char* VT = C.lds + 64 * 528;
    const float cdec = fexp2(128.0f * lg2_gamma(h));
    f32x4 acc[2][4];
#pragma unroll
    for (int i = 0; i < 2; ++i)
#pragma unroll
        for (int j = 0; j < 4; ++j) acc[i][j] = (f32x4){0.f, 0.f, 0.f, 0.f};
#pragma unroll 1
    for (int c = 0; c < 32; ++c) {
        if (c > 0) {
#pragma unroll
            for (int i = 0; i < 2; ++i)
#pragma unroll
                for (int j = 0; j < 4; ++j) acc[i][j] = acc[i][j] * cdec;
        }
#pragma unroll 1
        for (int jh = 0; jh < 2; ++jh) {
            const size_t r0 = (size_t)b * SEQ + c * 128 + jh * 64;
            __syncthreads();
            for (int i = C.tid; i < 64 * 32; i += 512) { const int r = i >> 5, ch = i & 31; *(LAS u32x4*)(KT + r * 528 + ch * 16) = *(const u32x4*)(KR + (r0 + r) * DM + ch * 8); }
            { const int r = C.tid >> 3, ch = C.tid & 7; *(LAS u32x4*)(VT + r * 144 + ch * 16) = *(const u32x4*)(VR + (r0 + r) * RV + ch * 8); }
            __syncthreads();
#pragma unroll
            for (int ks = 0; ks < 2; ++ks) {
                bf16x8 A[2], B[4];
                const int rr = 32 * ks + 8 * g + q4;
#pragma unroll
                for (int md = 0; md < 2; ++md) A[md] = cat8(tr16(KT + rr * 528 + (32 * w + 16 * md) * 2 + 8 * p4), tr16(KT + (rr + 4) * 528 + (32 * w + 16 * md) * 2 + 8 * p4));
#pragma unroll
                for (int nv = 0; nv < 4; ++nv) B[nv] = cat8(tr16(VT + rr * 144 + (16 * nv) * 2 + 8 * p4), tr16(VT + (rr + 4) * 144 + (16 * nv) * 2 + 8 * p4));
#pragma unroll
                for (int md = 0; md < 2; ++md)
#pragma unroll
                    for (int nv = 0; nv < 4; ++nv) acc[md][nv] = mfma16(A[md], B[nv], acc[md][nv]);
            }
        }
        if (c < 31) {
#pragma unroll
            for (int md = 0; md < 2; ++md)
#pragma unroll
                for (int nv = 0; nv < 4; ++nv) { const int v = sl * 64 + 16 * nv + (lane & 15), d = 32 * w + 16 * md + 4 * g;
                    *(u32x2*)(ST + (((size_t)(bh * 31 + c) * 512 + v) * 256 + d)) = (u32x2){cvt_pk_bf16(acc[md][nv][0], acc[md][nv][1]), cvt_pk_bf16(acc[md][nv][2], acc[md][nv][3])}; }
        } else {
            float* SP = C.out + O_SP + (size_t)bh * 256 * 512;
#pragma unroll
            for (int md = 0; md < 2; ++md)
#pragma unroll
                for (int nv = 0; nv < 4; ++nv)
#pragma unroll
                    for (int r = 0; r < 4; ++r) SP[(size_t)(32 * w + 16 * md + 4 * g + r) * 512 + sl * 64 + 16 * nv + (lane & 15)] = acc[md][nv][r];
        }
    }
}

__device__ __forceinline__ void attn_unit(const Ctx& C, int uid) {
    const int b = uid / 384; int rem = uid % 384; const int grp = rem >> 7; rem &= 127; const int head = rem >> 5, sb = rem & 31;
    const int dil = 1 << (2 * grp), nblk = 32 >> (2 * grp), r = sb / nblk, nb = sb % nblk;
    const int col0 = grp * 512 + head * 128, lane = opaque(C.lane), w = C.wave, g = lane >> 4, q4 = (lane & 15) >> 2, p4 = lane & 3;
    const bf16_t* QA = WSP(const bf16_t, WS_QA); const bf16_t* KA = WSP(const bf16_t, WS_KA); const bf16_t* VA = WSP(const bf16_t, WS_VA);
    LAS unsigned char* KT = C.lds; LAS unsigned char* VT = C.lds + 256 * 272;
    __syncthreads();
    for (int i = C.tid; i < 256 * 16; i += 512) { const int jj = i >> 4, ch = i & 15; int n = 128 * (nb - 1) + jj; n = n < 0 ? 0 : n;
        const size_t row = (size_t)b * SEQ + (size_t)n * dil + r;
        *(LAS u32x4*)(KT + jj * 272 + ch * 16) = *(const u32x4*)(KA + row * AW + col0 + ch * 8);
        *(LAS u32x4*)(VT + jj * 272 + ch * 16) = *(const u32x4*)(VA + row * AW + col0 + ch * 8); }
    const int qi = 16 * w + (lane & 15); const size_t qrow = (size_t)b * SEQ + (size_t)(128 * nb + qi) * dil + r;
    bf16x8 qf[4];
#pragma unroll
    for (int ks = 0; ks < 4; ++ks) qf[ks] = *(const bf16x8*)(QA + qrow * AW + col0 + 32 * ks + 8 * g);
    __syncthreads();
    f32x4 s[16];
#pragma unroll
    for (int kt = 0; kt < 16; ++kt) { s[kt] = (f32x4){0.f, 0.f, 0.f, 0.f};
#pragma unroll
        for (int ks = 0; ks < 4; ++ks) { const bf16x8 a = *(const LAS bf16x8*)(KT + (16 * kt + (lane & 15)) * 272 + (32 * ks + 8 * g) * 2); s[kt] = mfma16(a, qf[ks], s[kt]); } }
    float mx = -INFINITY;
#pragma unroll
    for (int kt = 0; kt < 16; ++kt)
#pragma unroll
        for (int rg = 0; rg < 4; ++rg) { const int key = 16 * kt + 4 * g + rg; const bool ok = key >= qi && key <= qi + 128 && (nb > 0 || key >= 128);
            s[kt][rg] = ok ? s[kt][rg] : -INFINITY; mx = fmaxf(mx, s[kt][rg]); }
    mx = fmaxf(mx, __shfl_xor(mx, 16)); mx = fmaxf(mx, __shfl_xor(mx, 32));
    float l = 0.f;
#pragma unroll
    for (int kt = 0; kt < 16; ++kt)
#pragma unroll
        for (int rg = 0; rg < 4; ++rg) { const float p = fexp2(s[kt][rg] - mx); s[kt][rg] = p; l += p; }
    l += __shfl_xor(l, 16); l += __shfl_xor(l, 32);
    f32x4 o[8];
#pragma unroll
    for (int ne = 0; ne < 8; ++ne) o[ne] = (f32x4){0.f, 0.f, 0.f, 0.f};
#pragma unroll
    for (int kp = 0; kp < 8; ++kp) {
        bf16x8 pf; { const u32x4 wv = pack8(s[2 * kp], s[2 * kp + 1]); pf = __builtin_bit_cast(bf16x8, wv); }
        const int r0 = 32 * kp + 4 * g + q4;
#pragma unroll
        for (int ne = 0; ne < 8; ++ne) { const bf16x8 a = cat8(tr16(VT + r0 * 272 + (16 * ne) * 2 + 8 * p4), tr16(VT + (r0 + 16) * 272 + (16 * ne) * 2 + 8 * p4)); o[ne] = mfma16(a, pf, o[ne]); }
    }
    const float linv = frcp(l);
    bf16_t* OG = WSP(bf16_t, WS_OG) + qrow * AW + col0 + 4 * g;
#pragma unroll
    for (int ne = 0; ne < 8; ++ne) { const f32x4 v = o[ne] * linv; *(u32x2*)(OG + 16 * ne) = (u32x2){cvt_pk_bf16(v[0], v[1]), cvt_pk_bf16(v[2], v[3])}; }
    if (g == 0) WSP(float, WS_LSE)[qrow * 12 + grp * 4 + head] = (mx + flog2(l)) * LN2;
}

__device__ __forceinline__ void samp_state_task(const Ctx& C, int task) {
    const int bs = task >> 3, h = (task >> 1) & 3, vh = task & 1, tid = opaque(C.tid), cg4 = tid & 63, rg = tid >> 6;
    LAS float* qs = (LAS float*)C.lds; LAS float* ks = qs + 256; LAS float* red = ks + 256;
    const size_t row = TP + bs;
    __syncthreads();
    if (tid < 256) { qs[tid] = bf2f(WSP(const bf16_t, WS_QR)[row * DM + h * 256 + tid]); ks[tid] = bf2f(WSP(const bf16_t, WS_KR)[row * DM + h * 256 + tid]); }
    const bf16_t* vp = WSP(const bf16_t, WS_VR) + row * RV + h * 512 + vh * 256 + cg4 * 4;
    const u32x2 vw = *(const u32x2*)vp; const f32x4 vv = (f32x4){bflo(vw.x), bfhi(vw.x), bflo(vw.y), bfhi(vw.y)};
    const float gam = 1.0f - exp2f(-(float)(5 + h));
    const size_t sbase = ((size_t)(bs * 4 + h) * 256) * 512 + vh * 256 + cg4 * 4;
    const float* S0 = C.ka->in[2] + sbase; float* S1 = C.out + O_SS + sbase;
    __syncthreads();
    f32x4 oacc = (f32x4){0.f, 0.f, 0.f, 0.f};
#pragma unroll 4
    for (int i = 0; i < 32; ++i) { const int d = rg + 8 * i; const f32x4 s0 = *(const f32x4*)(S0 + (size_t)d * 512); const f32x4 sn = s0 * gam + vv * ks[d]; *(f32x4*)(S1 + (size_t)d * 512) = sn; oacc += sn * qs[d]; }
    *(LAS f32x4*)(red + rg * 256 + cg4 * 4) = oacc;
    __syncthreads();
    if (tid < 256) { float s = 0.f;
#pragma unroll
        for (int k = 0; k < 8; ++k) s += red[k * 256 + tid];
        WSP(float, WS_OS)[(size_t)(bs * 4 + h) * 512 + vh * 256 + tid] = s; }
}

__device__ __forceinline__ void samp_attn_wave(const Ctx& C, int wt) {
    const int bs = wt / 12, grp = (wt % 12) >> 2, head = wt & 3, lane = opaque(C.lane);
    const int dil = 1 << (2 * grp), Wb = 128 * dil; const size_t row = TP + bs; const int col0 = grp * 512 + head * 128;
    const float *c3 = C.ka->in[3], *c4 = C.ka->in[4], *c5 = C.ka->in[5];
    asm volatile("" : "+s"(c3), "+s"(c4), "+s"(c5));
    const float* cache = (grp == 0 ? c3 : grp == 1 ? c4 : c5) + (size_t)bs * Wb * 1024 + head * 128 + 2 * lane;
    LAS float* sc = (LAS float*)(C.lds + 65536 + C.wave * 1024);
    const unsigned qw = *(const unsigned*)(WSP(const bf16_t, WS_QA) + row * AW + col0 + 2 * lane); const float q0 = bflo(qw), q1 = bfhi(qw);
    const unsigned kw = *(const unsigned*)(WSP(const bf16_t, WS_KA) + row * AW + col0 + 2 * lane);
    const unsigned vw = *(const unsigned*)(WSP(const bf16_t, WS_VA) + row * AW + col0 + 2 * lane);
    { const float d = wave_sum(q0 * bflo(kw) + q1 * bfhi(kw)); if (lane == 0) sc[0] = d; }
    for (int m0 = 1; m0 <= 128; m0 += 8) {
        float d[8];
#pragma unroll
        for (int u = 0; u < 8; ++u) { const f32x2 kk = *(const f32x2*)(cache + (size_t)(Wb - dil * (m0 + u)) * 1024); d[u] = q0 * kk[0] + q1 * kk[1]; }
#pragma unroll
        for (int u = 0; u < 8; ++u) { const float t = wave_sum(d[u]); if (lane == 0) sc[m0 + u] = t; }
    }
    asm volatile("s_waitcnt lgkmcnt(0)" ::: "memory");
    float s0 = sc[lane], s1 = sc[lane + 64], s2 = lane == 0 ? sc[128] : -INFINITY;
    float mx = fmaxf(fmaxf(s0, s1), s2);
#pragma unroll
    for (int o = 1; o < 64; o <<= 1) mx = fmaxf(mx, __shfl_xor(mx, o));
    const float p0 = fexp2(s0 - mx), p1 = fexp2(s1 - mx), p2 = lane == 0 ? fexp2(s2 - mx) : 0.f;
    const float l = wave_sum(p0 + p1 + p2);
    sc[lane] = p0; sc[lane + 64] = p1; if (lane == 0) sc[128] = p2;
    asm volatile("s_waitcnt lgkmcnt(0)" ::: "memory");
    float o0 = sc[0] * bflo(vw), o1 = sc[0] * bfhi(vw);
    for (int m0 = 1; m0 <= 128; m0 += 8) {
        f32x2 vv[8];
#pragma unroll
        for (int u = 0; u < 8; ++u) vv[u] = *(const f32x2*)(cache + (size_t)(Wb - dil * (m0 + u)) * 1024 + 512);
#pragma unroll
        for (int u = 0; u < 8; ++u) { const float p = sc[m0 + u]; o0 += p * vv[u][0]; o1 += p * vv[u][1]; }
    }
    const float linv = frcp(l);
    *(unsigned*)(WSP(bf16_t, WS_OG) + row * AW + col0 + 2 * lane) = cvt_pk_bf16(o0 * linv, o1 * linv);
    if (lane == 0) WSP(float, WS_LSE)[row * 12 + grp * 4 + head] = (mx + flog2(l)) * LN2;
}

__device__ __forceinline__ void ret_out_task(const Ctx& C, int task) {
    const int bh = task >> 5, c = task & 31, b = bh >> 2, h = bh & 3, lane = opaque(C.lane), w = C.wave, g = lane >> 4, q4 = (lane & 15) >> 2, p4 = lane & 3, l15 = lane & 15;
    const size_t r0 = (size_t)b * SEQ + c * 128;
    const bf16_t* QR = WSP(const bf16_t, WS_QR) + r0 * DM + h * 256; const bf16_t* KR = WSP(const bf16_t, WS_KR) + r0 * DM + h * 256;
    const bf16_t* VR = WSP(const bf16_t, WS_VR) + r0 * RV + h * 512;
    LAS unsigned char* QT = C.lds;
    LAS unsigned char* PT = C.lds + 18432;
    LAS unsigned char* XT = C.lds + 53248;
    const float ginv = fexp2(-128.0f * lg2_gamma(h));
    {
        f32x4 a1[8];
#pragma unroll
        for (int jt = 0; jt < 8; ++jt) a1[jt] = (f32x4){0.f, 0.f, 0.f, 0.f};
#pragma unroll 1
        for (int dt = 0; dt < 4; ++dt) {
            __syncthreads();
            for (int i = C.tid; i < 128 * 8; i += 512) { const int r = i >> 3, ch = i & 7;
                *(LAS u32x4*)(QT + r * 144 + ch * 16) = *(const u32x4*)(QR + (size_t)r * DM + dt * 64 + ch * 8);
                *(LAS u32x4*)(XT + r * 144 + ch * 16) = *(const u32x4*)(KR + (size_t)r * DM + dt * 64 + ch * 8); }
            __syncthreads();
#pragma unroll
            for (int ks = 0; ks < 2; ++ks) {
                const bf16x8 bq = *(const LAS bf16x8*)(QT + (16 * w + l15) * 144 + (32 * ks + 8 * g) * 2);
#pragma unroll
                for (int jt = 0; jt < 8; ++jt) if (jt <= w) { const bf16x8 ak = *(const LAS bf16x8*)(XT + (16 * jt + l15) * 144 + (32 * ks + 8 * g) * 2); a1[jt] = mfma16(ak, bq, a1[jt]); }
            }
        }
        const int i = 16 * w + l15;
#pragma unroll
        for (int jt = 0; jt < 8; ++jt) { f32x4 v = a1[jt] * ginv;
#pragma unroll
            for (int rg = 0; rg < 4; ++rg) { const int j = 16 * jt + 4 * g + rg; if (jt > w || j > i) v[rg] = 0.f; }
            *(LAS u32x2*)(PT + i * 272 + (16 * jt + 4 * g) * 2) = (u32x2){cvt_pk_bf16(v[0], v[1]), cvt_pk_bf16(v[2], v[3])}; }
    }
    f32x4 a2[8][4];
#pragma unroll
    for (int it = 0; it < 8; ++it)
#pragma unroll
        for (int vt = 0; vt < 4; ++vt) a2[it][vt] = (f32x4){0.f, 0.f, 0.f, 0.f};
    if (c > 0) {
        const bf16_t* STc = WSP(const bf16_t, WS_ST) + (size_t)(bh * 31 + (c - 1)) * 512 * 256;
#pragma unroll 1
        for (int dt = 0; dt < 4; ++dt) {
            __syncthreads();
            for (int i = C.tid; i < 128 * 8; i += 512) { const int r = i >> 3, ch = i & 7; *(LAS u32x4*)(QT + r * 144 + ch * 16) = *(const u32x4*)(QR + (size_t)r * DM + dt * 64 + ch * 8); }
            for (int i = C.tid; i < 512 * 8; i += 512) { const int r = i >> 3, ch = i & 7; *(LAS u32x4*)(XT + r * 144 + ch * 16) = *(const u32x4*)(STc + (size_t)r * 256 + dt * 64 + ch * 8); }
            __syncthreads();
#pragma unroll
            for (int ks = 0; ks < 2; ++ks) {
                bf16x8 A[4];
#pragma unroll
                for (int vt = 0; vt < 4; ++vt) A[vt] = *(const LAS bf16x8*)(XT + (64 * w + 16 * vt + l15) * 144 + (32 * ks + 8 * g) * 2);
#pragma unroll
                for (int it = 0; it < 8; ++it) { const bf16x8 B = *(const LAS bf16x8*)(QT + (16 * it + l15) * 144 + (32 * ks + 8 * g) * 2);
#pragma unroll
                    for (int vt = 0; vt < 4; ++vt) a2[it][vt] = mfma16(A[vt], B, a2[it][vt]); }
            }
        }
    }
#pragma unroll 1
    for (int jt2 = 0; jt2 < 2; ++jt2) {
        __syncthreads();
        for (int i = C.tid; i < 64 * 64; i += 512) { const int r = i >> 6, ch = i & 63; *(LAS u32x4*)(XT + r * 1040 + ch * 16) = *(const u32x4*)(VR + (size_t)(jt2 * 64 + r) * RV + ch * 8); }
        __syncthreads();
#pragma unroll
        for (int ks = 0; ks < 2; ++ks) {
            bf16x8 A[4];
            const int rr = 32 * ks + 8 * g + q4;
#pragma unroll
            for (int vt = 0; vt < 4; ++vt) A[vt] = cat8(tr16(XT + rr * 1040 + (64 * w + 16 * vt) * 2 + 8 * p4), tr16(XT + (rr + 4) * 1040 + (64 * w + 16 * vt) * 2 + 8 * p4));
#pragma unroll
            for (int it = 0; it < 8; ++it) { const bf16x8 B = *(const LAS bf16x8*)(PT + (16 * it + l15) * 272 + (jt2 * 64 + 32 * ks + 8 * g) * 2);
#pragma unroll
                for (int vt = 0; vt < 4; ++vt) a2[it][vt] = mfma16(A[vt], B, a2[it][vt]); }
        }
    }
    __syncthreads();
    LAS float* red = (LAS float*)C.lds;
#pragma unroll
    for (int it = 0; it < 8; ++it) { float s = 0.f;
#pragma unroll
        for (int vt = 0; vt < 4; ++vt) s += (a2[it][vt][0] * a2[it][vt][0] + a2[it][vt][1] * a2[it][vt][1]) + (a2[it][vt][2] * a2[it][vt][2] + a2[it][vt][3] * a2[it][vt][3]);
        s += __shfl_xor(s, 16); s += __shfl_xor(s, 32);
        if (g == 0) red[w * 128 + 16 * it + l15] = s; }
    __syncthreads();
    const float* gn = C.ka->in[8] + h * 512; const bf16_t* GS = WSP(const bf16_t, WS_GS) + r0 * RV + h * 512; bf16_t* APA = WSP(bf16_t, WS_APA) + r0 * RV + h * 512;
#pragma unroll
    for (int it = 0; it < 8; ++it) { const int i = 16 * it + l15; float s = 0.f;
#pragma unroll
        for (int k = 0; k < 8; ++k) s += red[k * 128 + i];
        const float rinv = rsqrtf(s * (1.0f / 512.0f) + EPS);
#pragma unroll
        for (int vt = 0; vt < 4; ++vt) { const int v = 64 * w + 16 * vt + 4 * g; const f32x4 gg = *(const f32x4*)(gn + v); const u32x2 gw = *(const u32x2*)(GS + (size_t)i * RV + v);
            const f32x4 y = a2[it][vt] * rinv * gg; *(u32x2*)(APA + (size_t)i * RV + v) = (u32x2){cvt_pk_bf16(y[0] * bflo(gw.x), y[1] * bfhi(gw.x)), cvt_pk_bf16(y[2] * bflo(gw.y), y[3] * bfhi(gw.y))}; }
        asm volatile("" ::: "memory");
    }
}
__device__ __forceinline__ void combine_row(const Ctx& C, int row) {
    const int lane = opaque(C.lane), slot = lane >> 4;
    const float* ls = WSP(const float, WS_LSE) + (size_t)row * 12 + slot; const float l0 = ls[0], l1 = ls[4], l2 = ls[8];
    const float mx = fmaxf(l0, fmaxf(l1, l2)); const float e0 = fexp2((l0 - mx) * 1.4426950408889634f), e1 = fexp2((l1 - mx) * 1.4426950408889634f), e2 = fexp2((l2 - mx) * 1.4426950408889634f);
    const float inv = frcp(e0 + e1 + e2);
    const bf16_t* og = WSP(const bf16_t, WS_OG) + (size_t)row * AW + lane * 8;
    f32x4 a0, a1, b0, b1, c0, c1; unpack8(*(const u32x4*)og, a0, a1); unpack8(*(const u32x4*)(og + 512), b0, b1); unpack8(*(const u32x4*)(og + 1024), c0, c1);
    const f32x4 r0 = (a0 * e0 + b0 * e1 + c0 * e2) * inv, r1 = (a1 * e0 + b1 * e1 + c1 * e2) * inv;
    *(u32x4*)(WSP(bf16_t, WS_OA) + (size_t)row * AOUT + lane * 8) = pack8(r0, r1);
}
__device__ __forceinline__ void samp_fin_wave(const Ctx& C, int wt) {
    const int bs = wt >> 2, h = wt & 3, lane = opaque(C.lane); const size_t row = TP + bs;
    const float* os = WSP(const float, WS_OS) + (size_t)wt * 512 + lane * 8;
    const f32x4 x0 = *(const f32x4*)os, x1 = *(const f32x4*)(os + 4);
    const float ss = wave_sum((x0[0] * x0[0] + x0[1] * x0[1]) + (x0[2] * x0[2] + x0[3] * x0[3]) + (x1[0] * x1[0] + x1[1] * x1[1]) + (x1[2] * x1[2] + x1[3] * x1[3]));
    const float rinv = rsqrtf(ss * (1.0f / 512.0f) + EPS);
    const float* gn = C.ka->in[8] + h * 512 + lane * 8; const f32x4 g0 = *(const f32x4*)gn, g1 = *(const f32x4*)(gn + 4);
    f32x4 s0, s1; unpack8(*(const u32x4*)(WSP(const bf16_t, WS_GS) + row * RV + h * 512 + lane * 8), s0, s1);
    *(u32x4*)(WSP(bf16_t, WS_APA) + row * RV + h * 512 + lane * 8) = pack8(x0 * rinv * g0 * s0, x1 * rinv * g1 * s1);
}

__device__ __forceinline__ void final_norm(const Ctx& C) {
    const int gw = C.bid * 8 + C.wave, NGW = C.G * 8, lane = C.lane;
    const f32x4* g4 = (const f32x4*)C.ka->in[15]; const float* RSS = WSP(const float, WS_RSS2);
    for (int row = gw; row < MR; row += NGW) {
        const f32x4* rp = (const f32x4*)(RSS + (size_t)row * 16); const f32x4 r0 = rp[0], r1 = rp[1], r2 = rp[2], r3 = rp[3];
        const float ssum = ((r0[0] + r0[1]) + (r0[2] + r0[3])) + ((r1[0] + r1[1]) + (r1[2] + r1[3])) + ((r2[0] + r2[1]) + (r2[2] + r2[3])) + ((r3[0] + r3[1]) + (r3[2] + r3[3]));
        const float rinv = rsqrtf(ssum * (1.0f / DM) + EPS);
        f32x4* y = (f32x4*)(C.out + (size_t)row * DM) + lane;
#pragma unroll
        for (int j = 0; j < 4; ++j) y[64 * j] = y[64 * j] * rinv * g4[lane + 64 * j];
    }
}

template <int PH_LO, int PH_HI>
__global__ void __launch_bounds__(512, 2) mk_fwd(Args args) {
    extern __shared__ __attribute__((aligned(16))) unsigned char lds_raw[];
    Ctx C; C.lds = (LAS unsigned char*)lds_raw; C.tid = threadIdx.x; C.lane = C.tid & 63; C.wave = __builtin_amdgcn_readfirstlane(C.tid >> 6); C.G = gridDim.x; C.bid = blockIdx.x;
    C.ka = (const __attribute__((address_space(4))) Args*)__builtin_amdgcn_kernarg_segment_ptr();
    C.out = args.out; C.ws = args.ws;
    unsigned* ctl = (unsigned*)(C.ws + WS_CTL);
    constexpr int lo = PH_LO, hi = PH_HI;
#if MK_FUSED
    cg::grid_group grid = cg::this_grid();
#define SEAM(k) do { if constexpr (lo <= (k) && (k) + 1 < hi) grid.sync(); } while (0)
#else
#define SEAM(k) do { } while (0)
#endif
#define IN(k) constexpr (lo <= (k) && (k) < hi)
    if IN(0) { p0_prep(C); }
    SEAM(0);
    if IN(1) {
        pg8::Gemm g{WSP(const bf16_t, WS_XN), WSP(const bf16_t, WS_WIN), MP, NIN, DM}; pg8::StaticOrder S; S.init(MP, NIN, C.G, C.bid);
        EpiIn E{C.ws, WSP(const float, WS_ROPEC), WSP(const float, WS_ROPES), C.out};
        pg8::gemm_phase<EpiIn, pg8::StaticOrder, true, true>(C.lds, g, S, E);
    }
    SEAM(1);
    if IN(2) {
        for (;;) {
            const int id = wq_next(C, ctl + CW_Q2);
            if (id < 128) ret_chain_task(C, id);
            else if (id < 128 + 1536) attn_unit(C, id - 128);
            else if (id < 1664 + 256) samp_state_task(C, id - 1664);
            else if (id < 1920 + 48) samp_attn_wave(C, (id - 1920) * 8 + C.wave);
            else break;
        }
    }
    SEAM(2);
    if IN(3) {
        for (;;) {
            const int id = wq_next(C, ctl + CW_Q3);
            if (id < 512) ret_out_task(C, id);
            else if (id < 512 + 65) { const int r0 = (id - 512) * 256 + C.wave * 32; for (int r = 0; r < 32; ++r) if (r0 + r < MR) combine_row(C, r0 + r); }
            else if (id < 577 + 16) samp_fin_wave(C, (id - 577) * 8 + C.wave);
            else break;
        }
    }
    SEAM(3);
    if IN(4) {
        pg8::Gemm g{WSP(const bf16_t, WS_APA), WSP(const bf16_t, WS_WPA), MP, DM, RV}; pg8::StaticOrder S; S.init(MP, DM, C.G, C.bid);
        EpiPa E{WSP(const bf16_t, WS_SGA), WSP(float, WS_P)};
        pg8::gemm_phase<EpiPa, pg8::StaticOrder, true, true>(C.lds, g, S, E);
    }
    if IN(5) {
        pg8::Gemm g{WSP(const bf16_t, WS_OA), WSP(const bf16_t, WS_WPB), MP, DM, AOUT}; pg8::StaticOrder S; S.init(MP, DM, C.G, C.bid);
        EpiPb E{WSP(const bf16_t, WS_SGB), WSP(const float, WS_P), WSP(bf16_t, WS_MERGED)};
        pg8::gemm_phase<EpiPb, pg8::StaticOrder, true, true>(C.lds, g, S, E);
    }
    SEAM(5);
    if IN(6) {
        pg8::Gemm g{WSP(const bf16_t, WS_MERGED), WSP(const bf16_t, WS_WO), MP, DM, DM}; pg8::StaticOrder S; S.init(MP, DM, C.G, C.bid);
        EpiO E{C.ka->in[0], C.ka->in[1], WSP(float, WS_H), WSP(bf16_t, WS_HB), WSP(float, WS_RSS1)};
        pg8::gemm_phase<EpiO, pg8::StaticOrder, true, true>(C.lds, g, S, E);
    }
    SEAM(6);
    if IN(7) {
        pg8::Gemm g{WSP(const bf16_t, WS_HB), WSP(const bf16_t, WS_WFI), MP, 2 * FH, DM}; pg8::StaticOrder S; S.init(MP, 2 * FH, C.G, C.bid);
        EpiFi E{WSP(const float, WS_RSS1), WSP(bf16_t, WS_HID)};
        pg8::gemm_phase<EpiFi, pg8::StaticOrder, true, true>(C.lds, g, S, E);
    }
    SEAM(7);
    if IN(8) {
        pg8::Gemm g{WSP(const bf16_t, WS_HID), WSP(const bf16_t, WS_WFO), MP, DM, FH}; pg8::StaticOrder S; S.init(MP, DM, C.G, C.bid);
        EpiFo E{WSP(const float, WS_H), C.out, WSP(float, WS_RSS2)};
        pg8::gemm_phase<EpiFo, pg8::StaticOrder, true, true>(C.lds, g, S, E);
    }
    SEAM(8);
    if IN(9) final_norm(C);
#undef IN
#undef SEAM
}

template <int LO, int HI> static void launch_range(int grid, const Args& a, hipStream_t stream) {
    static bool attr = false;
    if (!attr) { (void)hipFuncSetAttribute((const void*)mk_fwd<LO, HI>, hipFuncAttributeMaxDynamicSharedMemorySize, LDS_BYTES); attr = true; }
    hipLaunchKernelGGL((mk_fwd<LO, HI>), dim3(grid), dim3(512), LDS_BYTES, stream, a);
}
extern "C" void kernel_launch(void* const* d_in, const int* in_sizes, int n_in, void* d_out, int out_size, void* d_ws, size_t ws_size, hipStream_t stream) {
    static int grid = 0;
    if (grid == 0) {
        if (n_in != 16 || out_size != (int)O_END || ws_size < WS_END) { fprintf(stderr, "kernel_launch: unexpected shapes (n_in %d out %d ws %zu)\n", n_in, out_size, ws_size); grid = -1; return; }
        int dev = 0, cus = 0;
        (void)hipGetDevice(&dev); (void)hipDeviceGetAttribute(&cus, hipDeviceAttributeMultiprocessorCount, dev);
#if MK_FUSED
        int per_cu = 0;
        (void)hipFuncSetAttribute((const void*)mk_fwd<0, 10>, hipFuncAttributeMaxDynamicSharedMemorySize, LDS_BYTES);
        (void)hipOccupancyMaxActiveBlocksPerMultiprocessor(&per_cu, (const void*)mk_fwd<0, 10>, 512, LDS_BYTES);
        if (per_cu < 1) { fprintf(stderr, "kernel_launch: occupancy query says %d blocks per CU\n", per_cu); grid = -1; return; }
#endif
        (void)hipGetLastError();
        grid = cus;
    }
    if (grid < 0) return;
    (void)hipMemsetAsync((char*)d_ws + WS_CTL, 0, CTL_BYTES, stream);
    Args a{};
    for (int i = 0; i < 16; ++i) a.in[i] = (const float*)d_in[i];
    a.out = (float*)d_out; a.ws = (unsigned char*)d_ws;
#if MK_FUSED
    void* kargs[] = {&a};
    hipError_t e = hipLaunchCooperativeKernel((const void*)mk_fwd<0, 10>, dim3(grid), dim3(512), kargs, LDS_BYTES, stream);
    if (e != hipSuccess) fprintf(stderr, "cooperative launch failed: %s (grid %d)\n", hipGetErrorString(e), grid);
#else
    launch_range<0, 1>(grid, a, stream); launch_range<1, 2>(grid, a, stream); launch_range<2, 3>(grid, a, stream); launch_range<3, 4>(grid, a, stream);
    launch_range<4, 6>(grid, a, stream); launch_range<6, 7>(grid, a, stream); launch_range<7, 8>(grid, a, stream); launch_range<8, 9>(grid, a, stream); launch_range<9, 10>(grid, a, stream);
#endif
}
```

```cpp
#include <hip/hip_runtime.h>
#include <hip/hip_cooperative_groups.h>
#include <cstdio>
#include <cstdint>
namespace cg = cooperative_groups;

#ifndef MK_FUSED
#define MK_FUSED 1
#endif

#define LAS __attribute__((address_space(3)))
typedef unsigned short bf16_t;
typedef short bf16x8 __attribute__((ext_vector_type(8)));
typedef short s16x4 __attribute__((ext_vector_type(4)));
typedef float f32x4 __attribute__((ext_vector_type(4)));
typedef float f32x2 __attribute__((ext_vector_type(2)));
typedef unsigned u32x4 __attribute__((ext_vector_type(4)));
typedef unsigned u32x2 __attribute__((ext_vector_type(2)));

constexpr int DM = 1024, SEQ = 4096, NBATCH = 4, TP = NBATCH * SEQ  , NSAMP = 32, MR = TP + NSAMP  , MP = 16640  ;
constexpr int NIN = 12800, RV = 2048, AW = 1536, AOUT = 512, FH = 2816;
constexpr int PAST = 16384;
constexpr float EPS = 1e-6f;
constexpr size_t O_Y = 0, O_SP = 16809984, O_SS = 18907136, O_KV0P = 35684352, O_KV0S = 36208640, O_KV1P = 36241408, O_KV1S = 38338560, O_KV2P = 38371328, O_KV2S = 46759936, O_END = 46792704;
__device__ __forceinline__ float lg2_gamma(int h) { return h == 0 ? -0.04580368961312479f : h == 1 ? -0.02272007650008353f : h == 2 ? -0.011315313227834146f : -0.005646563141142063f; }
constexpr float QSCALE_A = 0.12751743082459868f;
constexpr float LN2 = 0.6931471805599453f;

constexpr size_t MiB = 1u << 20;
constexpr size_t al(size_t x) { return (x + MiB - 1) / MiB * MiB; }
constexpr size_t WS_CTL = 0, CTL_BYTES = MiB;
constexpr size_t WS_ROPEC = WS_CTL + CTL_BYTES, ROPE_BYTES = al((size_t)4097 * 128 * 4);
constexpr size_t WS_ROPES = WS_ROPEC + ROPE_BYTES;
constexpr size_t WS_WIN = WS_ROPES + ROPE_BYTES;
constexpr size_t WS_WPA = WS_WIN + al((size_t)NIN * DM * 2);
constexpr size_t WS_WPB = WS_WPA + al((size_t)DM * RV * 2);
constexpr size_t WS_WO = WS_WPB + al((size_t)DM * AOUT * 2);
constexpr size_t WS_WFI = WS_WO + al((size_t)DM * DM * 2);
constexpr size_t WS_WFO = WS_WFI + al((size_t)2 * FH * DM * 2);
constexpr size_t WS_XN = WS_WFO + al((size_t)DM * FH * 2);
constexpr size_t WS_QR = WS_XN + al((size_t)MP * DM * 2);
constexpr size_t WS_KR = WS_QR + (size_t)MP * DM * 2;
constexpr size_t WS_VR = WS_KR + al((size_t)MP * DM * 2);
constexpr size_t WS_GS = WS_VR + al((size_t)MP * RV * 2);
constexpr size_t WS_QA = WS_GS + al((size_t)MP * RV * 2);
constexpr size_t WS_KA = WS_QA + al((size_t)MP * AW * 2);
constexpr size_t WS_VA = WS_KA + al((size_t)MP * AW * 2);
constexpr size_t WS_SGA = WS_VA + al((size_t)MP * AW * 2);
constexpr size_t WS_SGB = WS_SGA + al((size_t)MP * DM * 2);
constexpr size_t WS_ST = WS_SGB + al((size_t)MP * DM * 2);
constexpr size_t WS_OG = WS_ST + al((size_t)16 * 31 * 512 * 256 * 2);
constexpr size_t WS_LSE = WS_OG + al((size_t)MP * AW * 2);
constexpr size_t WS_APA = WS_LSE + al((size_t)MP * 12 * 4);
constexpr size_t WS_OA = WS_APA + al((size_t)MP * RV * 2);
constexpr size_t WS_RSS1 = WS_OA + al((size_t)MP * AOUT * 2);
constexpr size_t WS_RSS2 = WS_RSS1 + al((size_t)MP * 16 * 4);
constexpr size_t WS_OS = WS_RSS2 + al((size_t)MP * 16 * 4);
constexpr size_t WS_END = WS_OS + MiB;
constexpr size_t WS_MERGED = WS_XN, WS_P = WS_QR, WS_H = WS_VR, WS_HB = WS_SGA, WS_HID = WS_ST;
static_assert((size_t)MP * FH * 2 <= (size_t)16 * 31 * 512 * 256 * 2, "HID overlays ST");
static_assert(WS_KR + (size_t)MP * DM * 2 - WS_QR >= (size_t)MP * DM * 4, "P overlays QR|KR");
static_assert(WS_END <= (size_t)1024 * MiB, "workspace map");
constexpr int CW_Q2 = 64, CW_Q3 = 128, CW_Q2B = 192, CW_Q3B = 256, CW_BAR = 4096;

constexpr int LDS_BYTES = 147456, LDS_MISC = 143360;

__device__ __forceinline__ unsigned cvt_pk_bf16(float lo, float hi) { unsigned r; asm volatile("v_cvt_pk_bf16_f32 %0, %1, %2" : "=v"(r) : "v"(lo), "v"(hi)); return r; }
__device__ __forceinline__ float bf2f(unsigned short b) { return __uint_as_float((unsigned)b << 16); }
__device__ __forceinline__ float bflo(unsigned w) { return __uint_as_float(w << 16); }
__device__ __forceinline__ float bfhi(unsigned w) { return __uint_as_float(w & 0xffff0000u); }
__device__ __forceinline__ float fexp2(float x) { return __builtin_amdgcn_exp2f(x); }
__device__ __forceinline__ float flog2(float x) { return __builtin_amdgcn_logf(x); }
__device__ __forceinline__ float frcp(float x) { return __builtin_amdgcn_rcpf(x); }
__device__ __forceinline__ float sigmoidf_(float x) { return frcp(1.0f + fexp2(-1.4426950408889634f * x)); }
__device__ __forceinline__ float siluf_(float x) { return x * sigmoidf_(x); }
__device__ __forceinline__ int opaque(int x) { asm volatile("" : "+v"(x)); return x; }
__device__ __forceinline__ float wave_sum(float v) {
#pragma unroll
    for (int o = 1; o < 64; o <<= 1) v += __shfl_xor(v, o);
    return v;
}
__device__ __forceinline__ s16x4 tr16(const LAS unsigned char* p) {
    typedef short v4i16_t __attribute__((ext_vector_type(4)));
    return __builtin_bit_cast(s16x4, __builtin_amdgcn_ds_read_tr16_b64_v4i16((LAS v4i16_t*)p));
}
__device__ __forceinline__ bf16x8 cat8(s16x4 a, s16x4 b) { bf16x8 r; r[0] = a[0]; r[1] = a[1]; r[2] = a[2]; r[3] = a[3]; r[4] = b[0]; r[5] = b[1]; r[6] = b[2]; r[7] = b[3]; return r; }
__device__ __forceinline__ f32x4 mfma16(bf16x8 a, bf16x8 b, f32x4 c) { return __builtin_amdgcn_mfma_f32_16x16x32_bf16(a, b, c, 0, 0, 0); }

namespace pg8 {
constexpr int BM = 256, BK = 64, HALF = 128, HTB = HALF * BK * 2, STAGE_BYTES = 8 * HTB, NXCD = 8, WGM = 8;
__host__ __device__ __forceinline__ int lds_byte(int r, int c) { const int st = (r >> 4) * 2 + (c >> 5), rr = r & 15, cc = c & 31, ob = rr * 64 + cc * 2; return st * 1024 + (ob ^ (((ob >> 9) & 1) << 5)); }
__host__ __device__ __forceinline__ void stage_rc(int b, int& R, int& C) { const int st = b / 1024, sb = b % 1024, swz = sb ^ (((sb >> 9) & 1) << 5); R = (st >> 1) * 16 + swz / 64; C = (st & 1) * 32 + (swz % 64) / 2; }
__host__ __device__ __forceinline__ int perm32(int rho) { const int n = rho >> 4, i = rho & 15; return 8 * (i >> 2) + 4 * n + (i & 3); }
struct Unit { int pm, pn; };
struct Gemm { const bf16_t* A; const bf16_t* Bt; int M, N, K; };
struct StaticOrder {
    int nM, nN, nwg, G, c;
    __host__ __device__ void init(int M, int N, int G_, int c_) { nM = M / BM; nN = N / BM; nwg = nM * nN; G = G_; c = c_; }
    __host__ __device__ bool next(int i, Unit& u) const {
        const long L = (long)i * G + c; if (L >= nwg) return false;
        int wgid = (int)L; { const int q = nwg / NXCD, r = nwg % NXCD, xcd = wgid % NXCD, off = wgid / NXCD; wgid = (xcd < r ? xcd * (q + 1) : r * (q + 1) + (xcd - r) * q) + off; }
        const int nig = WGM * nN, gid = wgid / nig, fm = gid * WGM, gsz = (nM - fm) < WGM ? (nM - fm) : WGM;
        u.pm = fm + ((wgid % nig) % gsz); u.pn = (wgid % nig) / gsz; return true;
    }
    __device__ __forceinline__ void a_ready(const Unit&) const {}
    __device__ __forceinline__ void done(const Unit&) const {}
};
template <class Epi, class Sched, bool ALIGN_EPI = false, bool SP2 = false>
__device__ __forceinline__ void gemm_phase(LAS unsigned char* lds, const Gemm g, const Sched& S, const Epi& E) {
    int tid_ = threadIdx.x; asm volatile("" : "+v"(tid_));
    const int tid = tid_, wid = __builtin_amdgcn_readfirstlane(tid >> 6), lane = tid & 63, wr = wid >> 2, wc = wid & 3, fr = lane & 15, fq = lane >> 4;
    const int K = g.K, nt = K / BK;
    unsigned voffA[2], voffB[2];
#pragma unroll
    for (int i = 0; i < 2; ++i) { int R, C; stage_rc(tid * 16 + i * 8192, R, C); const int Rb = Epi::PERM ? ((R & ~31) + perm32(R & 31)) : R;
        voffA[i] = (unsigned)(R * K + C) * 2u; voffB[i] = (unsigned)(Rb * K + C) * 2u; }
    const size_t kstep = (size_t)(BK * 2);
    const size_t hstep = (size_t)HALF * K * 2;
    const size_t tstep = 2 * hstep;
    const unsigned ldsw = (unsigned)wid * 1024u;
    const int aoff = lds_byte(wr * 64 + fr, fq * 8), boff = lds_byte(wc * 32 + fr, fq * 8);
#define PG8_SA(b, h) (((b) * 2 + (h)) * HTB)
#define PG8_SB(b, h) ((4 + (b) * 2 + (h)) * HTB)
#define PG8_STAGE(bufoff, gbase, voff) do { _Pragma("unroll") for (int _i = 0; _i < 2; ++_i) \
        __builtin_amdgcn_global_load_lds((const unsigned*)((const char*)(gbase) + (voff)[_i]), (LAS unsigned*)(lds + (bufoff) + ldsw + _i * 8192), 16, 0, 0); } while (0)
#define PG8_LDA(dst, b, h) do { _Pragma("unroll") for (int m = 0; m < 4; ++m) _Pragma("unroll") for (int k = 0; k < 2; ++k) dst[m][k] = *(const LAS bf16x8*)(lds + PG8_SA(b, h) + aoff + m * 2048 + k * 1024); } while (0)
#define PG8_LDB(dst, b, h) do { _Pragma("unroll") for (int n = 0; n < 2; ++n) _Pragma("unroll") for (int k = 0; k < 2; ++k) dst[n][k] = *(const LAS bf16x8*)(lds + PG8_SB(b, h) + boff + n * 2048 + k * 1024); } while (0)
#define PG8_MMA(ai, bj, At, Bt) do { __builtin_amdgcn_s_setprio(1); _Pragma("unroll") for (int m = 0; m < 4; ++m) _Pragma("unroll") for (int n = 0; n < 2; ++n) _Pragma("unroll") for (int k = 0; k < 2; ++k) \
        acc[ai][bj][m][n] = __builtin_amdgcn_mfma_f32_16x16x32_bf16(Bt[n][k], At[m][k], acc[ai][bj][m][n], 0, 0, 0); __builtin_amdgcn_s_setprio(0); } while (0)
#define PG8_WAIT_V(n) asm volatile("s_waitcnt vmcnt(" #n ")" ::: "memory")
#define PG8_WAIT_L(n) asm volatile("s_waitcnt lgkmcnt(" #n ")" ::: "memory")
#define PG8_BAR __builtin_amdgcn_s_barrier()
#define PG8_SCHED __builtin_amdgcn_sched_barrier(0)
    Unit cur, nxt; int ui = 0;
    if (!S.next(0, cur)) return;
    f32x4 acc[2][2][4][2];
#pragma unroll
    for (int a = 0; a < 2; ++a)
#pragma unroll
        for (int b = 0; b < 2; ++b)
#pragma unroll
            for (int m = 0; m < 4; ++m)
#pragma unroll
                for (int n = 0; n < 2; ++n) acc[a][b][m][n] = (f32x4){0.f, 0.f, 0.f, 0.f};
    bf16x8 At[4][2], B0[2][2], B1[2][2];
    const char* cA = (const char*)g.A + (size_t)cur.pm * tstep; const char* cB = (const char*)g.Bt + (size_t)cur.pn * tstep;
    S.a_ready(cur);
    if constexpr (SP2) {
        PG8_STAGE(PG8_SB(0, 0), cB, voffB); PG8_STAGE(PG8_SB(0, 1), cB + hstep, voffB); PG8_STAGE(PG8_SA(0, 0), cA, voffA); PG8_STAGE(PG8_SA(0, 1), cA + hstep, voffA);
        if (wr == 1) PG8_BAR;
        PG8_WAIT_V(2); PG8_BAR;
        PG8_STAGE(PG8_SB(1, 0), cB + kstep, voffB); PG8_STAGE(PG8_SA(1, 0), cA + kstep, voffA); PG8_STAGE(PG8_SB(1, 1), cB + hstep + kstep, voffB);
        PG8_WAIT_V(6); PG8_BAR;
    } else {
        PG8_STAGE(PG8_SB(0, 0), cB, voffB); PG8_STAGE(PG8_SA(0, 0), cA, voffA); PG8_STAGE(PG8_SB(0, 1), cB + hstep, voffB); PG8_STAGE(PG8_SA(0, 1), cA + hstep, voffA);
        if (wr == 1) PG8_BAR;
        PG8_WAIT_V(4); PG8_BAR;
        PG8_STAGE(PG8_SB(1, 0), cB + kstep, voffB); PG8_STAGE(PG8_SA(1, 0), cA + kstep, voffA); PG8_STAGE(PG8_SB(1, 1), cB + hstep + kstep, voffB);
        PG8_WAIT_V(6); PG8_BAR;
    }
    for (;;) {
        const bool has_next = S.next(ui + 1, nxt);
        const char* nA = has_next ? (const char*)g.A + (size_t)nxt.pm * tstep : cA; const char* nB = has_next ? (const char*)g.Bt + (size_t)nxt.pn * tstep : cB;
        for (int t = 0; t < nt; t += 2) {
            const bool last = (t == nt - 2);
            const char* a1 = cA + (size_t)(t + 1) * kstep;
            const char* a2 = last ? nA : cA + (size_t)(t + 2) * kstep; const char* b2 = last ? nB : cB + (size_t)(t + 2) * kstep;
            const char* a3 = a2 + kstep; const char* b3 = b2 + kstep;
            if (last && has_next) S.a_ready(nxt);
            if constexpr (SP2) {
            PG8_LDB(B0, 0, 0); PG8_LDB(B1, 0, 1); PG8_SCHED; PG8_LDA(At, 0, 0); PG8_STAGE(PG8_SA(1, 1), a1 + hstep, voffA);
            PG8_WAIT_V(8); PG8_WAIT_L(0); PG8_BAR; PG8_MMA(0, 0, At, B0); PG8_MMA(0, 1, At, B1); PG8_BAR; PG8_SCHED;
            PG8_LDA(At, 0, 1); PG8_STAGE(PG8_SB(0, 0), b2, voffB); PG8_STAGE(PG8_SB(0, 1), b2 + hstep, voffB); PG8_STAGE(PG8_SA(0, 0), a2, voffA);
            PG8_WAIT_V(8); PG8_WAIT_L(0); PG8_BAR; PG8_MMA(1, 0, At, B0); PG8_MMA(1, 1, At, B1); PG8_BAR; PG8_SCHED;
            PG8_LDB(B0, 1, 0); PG8_LDB(B1, 1, 1); PG8_SCHED; PG8_LDA(At, 1, 0); PG8_STAGE(PG8_SA(0, 1), a2 + hstep, voffA);
            PG8_WAIT_V(8); PG8_WAIT_L(0); PG8_BAR; PG8_MMA(0, 0, At, B0); PG8_MMA(0, 1, At, B1); PG8_BAR; PG8_SCHED;
            PG8_LDA(At, 1, 1); PG8_STAGE(PG8_SB(1, 0), b3, voffB); PG8_STAGE(PG8_SB(1, 1), b3 + hstep, voffB); PG8_STAGE(PG8_SA(1, 0), a3, voffA);
            PG8_WAIT_V(8); PG8_WAIT_L(0); PG8_BAR; PG8_MMA(1, 0, At, B0); PG8_MMA(1, 1, At, B1); PG8_BAR; PG8_SCHED;
            } else {
            PG8_LDB(B0, 0, 0); PG8_SCHED; PG8_LDA(At, 0, 0); PG8_STAGE(PG8_SA(1, 1), a1 + hstep, voffA);
            PG8_WAIT_L(8); PG8_BAR; PG8_WAIT_L(0); PG8_MMA(0, 0, At, B0); PG8_BAR; PG8_SCHED;
            PG8_LDB(B1, 0, 1); PG8_STAGE(PG8_SB(0, 0), b2, voffB);
            PG8_BAR; PG8_WAIT_L(0); PG8_MMA(0, 1, At, B1); PG8_BAR;
            PG8_LDA(At, 0, 1); PG8_STAGE(PG8_SA(0, 0), a2, voffA);
            PG8_BAR; PG8_WAIT_L(0); PG8_MMA(1, 0, At, B0); PG8_BAR; PG8_SCHED;
            PG8_STAGE(PG8_SB(0, 1), b2 + hstep, voffB);
            PG8_WAIT_V(6); PG8_BAR; PG8_MMA(1, 1, At, B1); PG8_BAR;
            PG8_LDB(B0, 1, 0); PG8_SCHED; PG8_LDA(At, 1, 0); PG8_STAGE(PG8_SA(0, 1), a2 + hstep, voffA);
            PG8_WAIT_L(8); PG8_BAR; PG8_WAIT_L(0); PG8_MMA(0, 0, At, B0); PG8_BAR; PG8_SCHED;
            PG8_LDB(B1, 1, 1); PG8_STAGE(PG8_SB(1, 0), b3, voffB);
            PG8_BAR; PG8_WAIT_L(0); PG8_MMA(0, 1, At, B1); PG8_BAR;
            PG8_LDA(At, 1, 1); PG8_STAGE(PG8_SA(1, 0), a3, voffA);
            PG8_BAR; PG8_WAIT_L(0); PG8_MMA(1, 0, At, B0); PG8_BAR; PG8_SCHED;
            PG8_STAGE(PG8_SB(1, 1), b3 + hstep, voffB);
            PG8_WAIT_V(6); PG8_BAR; PG8_MMA(1, 1, At, B1); PG8_BAR;
            }
        }
        if constexpr (ALIGN_EPI) { if (wr == 0) PG8_BAR; }
        if constexpr (!Epi::AFTER_DRAIN) { E(acc, cur, wr, wc, fr, fq); S.done(cur); }
        if (!has_next) break;
#pragma unroll
        for (int a = 0; a < 2; ++a)
#pragma unroll
            for (int b = 0; b < 2; ++b)
#pragma unroll
                for (int m = 0; m < 4; ++m)
#pragma unroll
                    for (int n = 0; n < 2; ++n) acc[a][b][m][n] = (f32x4){0.f, 0.f, 0.f, 0.f};
        cur = nxt; cA = nA; cB = nB; ++ui;
        if constexpr (ALIGN_EPI) { if (wr == 1) PG8_BAR; }
    }
    PG8_WAIT_V(0);
    if constexpr (!ALIGN_EPI) { if (wr == 0) PG8_BAR; }
    PG8_BAR;
#undef PG8_SA
#undef PG8_SB
#undef PG8_STAGE
#undef PG8_LDA
#undef PG8_LDB
#undef PG8_MMA
#undef PG8_WAIT_V
#undef PG8_WAIT_L
#undef PG8_BAR
#undef PG8_SCHED
}
}
using pg8::Unit;

__device__ __forceinline__ u32x4 pack8(f32x4 a, f32x4 b) { u32x4 w; w.x = cvt_pk_bf16(a[0], a[1]); w.y = cvt_pk_bf16(a[2], a[3]); w.z = cvt_pk_bf16(b[0], b[1]); w.w = cvt_pk_bf16(b[2], b[3]); return w; }
__device__ __forceinline__ void unpack8(u32x4 w, f32x4& a, f32x4& b) { a[0] = bflo(w.x); a[1] = bfhi(w.x); a[2] = bflo(w.y); a[3] = bfhi(w.y); b[0] = bflo(w.z); b[1] = bfhi(w.z); b[2] = bflo(w.w); b[3] = bfhi(w.w); }

struct EpiIn {
    static constexpr bool PERM = true, AFTER_DRAIN = false;
    unsigned char* ws; const float *ropec, *ropes; float* out;
    __device__ __forceinline__ void operator()(const f32x4 (&acc)[2][2][4][2], const Unit& u, int wr, int wc, int fr, int fq) const {
        const int pn = u.pn, rbase = u.pm * 256 + wr * 64 + fr, cb = wc * 32 + 8 * fq;
        if (pn < 8) {
            const int h = pn & 3; const bool isq = pn < 4; bf16_t* dst = (bf16_t*)(ws + (isq ? WS_QR : WS_KR)); const float lg = lg2_gamma(h);
#pragma unroll
            for (int ai = 0; ai < 2; ++ai)
#pragma unroll
                for (int m = 0; m < 4; ++m) {
                    const int row = rbase + ai * 128 + m * 16; const int pidx = row < TP ? (row & (SEQ - 1)) : 4096;
                    float sc;
                    if (row < TP) { const int tt = row & 127; sc = isq ? fexp2((float)(tt + 1) * lg) : 0.0625f * fexp2((float)(127 - tt) * lg); } else sc = isq ? 1.0f : 0.0625f;
                    f32x4 o1[2], o2[2];
#pragma unroll
                    for (int n = 0; n < 2; ++n) {
                        const f32x4 c = *(const f32x4*)(ropec + (size_t)pidx * 128 + cb + 4 * n), s = *(const f32x4*)(ropes + (size_t)pidx * 128 + cb + 4 * n);
                        const f32x4 x1 = acc[ai][0][m][n], x2 = acc[ai][1][m][n];
                        o1[n] = (x1 * c - x2 * s) * sc; o2[n] = (x1 * s + x2 * c) * sc;
                    }
                    bf16_t* p = dst + (size_t)row * DM + h * 256 + cb;
                    *(u32x4*)p = pack8(o1[0], o1[1]); *(u32x4*)(p + 128) = pack8(o2[0], o2[1]);
                }
            return;
        }
        size_t doff; int ld, col0; int mode = 0; float scl = 1.0f;
        if (pn < 16) { doff = WS_VR; ld = RV; col0 = (pn - 8) * 256; }
        else if (pn < 24) { doff = WS_GS; ld = RV; col0 = (pn - 16) * 256; mode = 1; }
        else if (pn < 30) { doff = WS_QA; ld = AW; col0 = (pn - 24) * 256; scl = QSCALE_A; }
        else if (pn < 36) { doff = WS_KA; ld = AW; col0 = (pn - 30) * 256; }
        else if (pn < 42) { doff = WS_VA; ld = AW; col0 = (pn - 36) * 256; }
        else if (pn < 46) { doff = WS_SGA; ld = DM; col0 = (pn - 42) * 256; mode = 2; }
        else { doff = WS_SGB; ld = DM; col0 = (pn - 46) * 256; mode = 2; }
        bf16_t* dst = (bf16_t*)(ws + doff);
        const bool iskv = pn >= 30 && pn < 42;
        int kvsel = 0, grp = 0, half = 0, win = 0; size_t obp = 0, obs = 0;
        if (iskv) { const int idx = pn >= 36 ? pn - 36 : pn - 30; kvsel = pn >= 36 ? 1 : 0; grp = idx >> 1; half = idx & 1; win = 128 << (2 * grp);
            obp = grp == 0 ? O_KV0P : grp == 1 ? O_KV1P : O_KV2P; obs = grp == 0 ? O_KV0S : grp == 1 ? O_KV1S : O_KV2S; }
#pragma unroll
        for (int ai = 0; ai < 2; ++ai)
#pragma unroll
            for (int m = 0; m < 4; ++m) {
                const int row = rbase + ai * 128 + m * 16;
#pragma unroll
                for (int bj = 0; bj < 2; ++bj) {
                    f32x4 v0 = acc[ai][bj][m][0], v1 = acc[ai][bj][m][1];
                    if (iskv) {
                        float* op = nullptr;
                        if (row < TP) { const int t = row & (SEQ - 1), b = row >> 12; if (t >= SEQ - win) op = out + obp + ((size_t)(b * win + (t - (SEQ - win))) * 2 + kvsel) * 512 + half * 256 + bj * 128 + cb; }
                        else if (row < MR) op = out + obs + ((size_t)(row - TP) * 2 + kvsel) * 512 + half * 256 + bj * 128 + cb;
                        if (op) { *(f32x4*)op = v0; *(f32x4*)(op + 4) = v1; }
                    }
                    if (mode == 1) {
#pragma unroll
                        for (int i = 0; i < 4; ++i) { v0[i] = siluf_(v0[i]); v1[i] = siluf_(v1[i]); }
                    } else if (mode == 2) {
#pragma unroll
                        for (int i = 0; i < 4; ++i) { v0[i] = sigmoidf_(v0[i]); v1[i] = sigmoidf_(v1[i]); }
                    } else { v0 = v0 * scl; v1 = v1 * scl; }
                    *(u32x4*)(dst + (size_t)row * ld + col0 + bj * 128 + cb) = pack8(v0, v1);
                }
            }
    }
};

struct EpiPa {
    static constexpr bool PERM = true, AFTER_DRAIN = false;
    const bf16_t* SGA; float* P;
    __device__ __forceinline__ void operator()(const f32x4 (&acc)[2][2][4][2], const Unit& u, int wr, int wc, int fr, int fq) const {
        const int rbase = u.pm * 256 + wr * 64 + fr, cb = u.pn * 256 + wc * 32 + 8 * fq;
#pragma unroll
        for (int ai = 0; ai < 2; ++ai)
#pragma unroll
            for (int m = 0; m < 4; ++m) { const size_t ro = (size_t)(rbase + ai * 128 + m * 16) * DM + cb;
#pragma unroll
                for (int bj = 0; bj < 2; ++bj) { f32x4 g0, g1; unpack8(*(const u32x4*)(SGA + ro + bj * 128), g0, g1);
                    *(f32x4*)(P + ro + bj * 128) = acc[ai][bj][m][0] * g0; *(f32x4*)(P + ro + bj * 128 + 4) = acc[ai][bj][m][1] * g1; } }
    }
};
struct EpiPb {
    static constexpr bool PERM = true, AFTER_DRAIN = false;
    const bf16_t* SGB; const float* P; bf16_t* MG;
    __device__ __forceinline__ void operator()(const f32x4 (&acc)[2][2][4][2], const Unit& u, int wr, int wc, int fr, int fq) const {
        const int rbase = u.pm * 256 + wr * 64 + fr, cb = u.pn * 256 + wc * 32 + 8 * fq;
#pragma unroll
        for (int ai = 0; ai < 2; ++ai)
#pragma unroll
            for (int m = 0; m < 4; ++m) { const size_t ro = (size_t)(rbase + ai * 128 + m * 16) * DM + cb;
#pragma unroll
                for (int bj = 0; bj < 2; ++bj) { f32x4 g0, g1; unpack8(*(const u32x4*)(SGB + ro + bj * 128), g0, g1);
                    const f32x4 p0 = *(const f32x4*)(P + ro + bj * 128), p1 = *(const f32x4*)(P + ro + bj * 128 + 4);
                    *(u32x4*)(MG + ro + bj * 128) = pack8(p0 + acc[ai][bj][m][0] * g0, p1 + acc[ai][bj][m][1] * g1); } }
    }
};
struct EpiO {
    static constexpr bool PERM = true, AFTER_DRAIN = false;
    const float *xp, *xs; float* H; bf16_t* HB; float* RSS;
    __device__ __forceinline__ void operator()(const f32x4 (&acc)[2][2][4][2], const Unit& u, int wr, int wc, int fr, int fq) const {
        const int rbase = u.pm * 256 + wr * 64 + fr, cb = u.pn * 256 + wc * 32 + 8 * fq;
#pragma unroll
        for (int ai = 0; ai < 2; ++ai)
#pragma unroll
            for (int m = 0; m < 4; ++m) { const int row = rbase + ai * 128 + m * 16; const size_t ro = (size_t)row * DM + cb;
                const float* xr = row < TP ? xp + ro : (row < MR ? xs + (size_t)(row - TP) * DM + cb : nullptr);
                float ss = 0.f;
#pragma unroll
                for (int bj = 0; bj < 2; ++bj) {
                    f32x4 x0 = (f32x4){0.f, 0.f, 0.f, 0.f}, x1 = x0; if (xr) { x0 = *(const f32x4*)(xr + bj * 128); x1 = *(const f32x4*)(xr + bj * 128 + 4); }
                    const f32x4 h0 = x0 + acc[ai][bj][m][0], h1 = x1 + acc[ai][bj][m][1];
                    *(f32x4*)(H + ro + bj * 128) = h0; *(f32x4*)(H + ro + bj * 128 + 4) = h1; *(u32x4*)(HB + ro + bj * 128) = pack8(h0, h1);
                    ss += (h0[0] * h0[0] + h0[1] * h0[1]) + (h0[2] * h0[2] + h0[3] * h0[3]) + (h1[0] * h1[0] + h1[1] * h1[1]) + (h1[2] * h1[2] + h1[3] * h1[3]);
                }
                ss += __shfl_xor(ss, 16); ss += __shfl_xor(ss, 32);
                if (fq == 0) RSS[(size_t)row * 16 + u.pn * 4 + wc] = ss;
            }
    }
};
struct EpiFi {
    static constexpr bool PERM = true, AFTER_DRAIN = false;
    const float* RSS; bf16_t* HID;
    __device__ __forceinline__ void operator()(const f32x4 (&acc)[2][2][4][2], const Unit& u, int wr, int wc, int fr, int fq) const {
        const int rbase = u.pm * 256 + wr * 64 + fr, cb = u.pn * 128 + wc * 32 + 8 * fq;
#pragma unroll
        for (int ai = 0; ai < 2; ++ai)
#pragma unroll
            for (int m = 0; m < 4; ++m) { const int row = rbase + ai * 128 + m * 16;
                const f32x4* rp = (const f32x4*)(RSS + (size_t)row * 16); const f32x4 r0 = rp[0], r1 = rp[1], r2 = rp[2], r3 = rp[3];
                const float ssum = ((r0[0] + r0[1]) + (r0[2] + r0[3])) + ((r1[0] + r1[1]) + (r1[2] + r1[3])) + ((r2[0] + r2[1]) + (r2[2] + r2[3])) + ((r3[0] + r3[1]) + (r3[2] + r3[3]));
                const float rinv = rsqrtf(ssum * (1.0f / DM) + EPS);
                f32x4 o[2];
#pragma unroll
                for (int n = 0; n < 2; ++n) { const f32x4 a = acc[ai][0][m][n] * rinv, b = acc[ai][1][m][n] * rinv;
#pragma unroll
                    for (int i = 0; i < 4; ++i) o[n][i] = siluf_(a[i]) * b[i]; }
                *(u32x4*)(HID + (size_t)row * FH + cb) = pack8(o[0], o[1]);
            }
    }
};
struct EpiFo {
    static constexpr bool PERM = true, AFTER_DRAIN = false;
    const float* H; float* Y; float* RSS;
    __device__ __forceinline__ void operator()(const f32x4 (&acc)[2][2][4][2], const Unit& u, int wr, int wc, int fr, int fq) const {
        const int rbase = u.pm * 256 + wr * 64 + fr, cb = u.pn * 256 + wc * 32 + 8 * fq;
#pragma unroll
        for (int ai = 0; ai < 2; ++ai)
#pragma unroll
            for (int m = 0; m < 4; ++m) { const int row = rbase + ai * 128 + m * 16; const size_t ro = (size_t)row * DM + cb;
                float ss = 0.f;
#pragma unroll
                for (int bj = 0; bj < 2; ++bj) {
                    const f32x4 h0 = *(const f32x4*)(H + ro + bj * 128) + acc[ai][bj][m][0], h1 = *(const f32x4*)(H + ro + bj * 128 + 4) + acc[ai][bj][m][1];
                    if (row < MR) { *(f32x4*)(Y + ro + bj * 128) = h0; *(f32x4*)(Y + ro + bj * 128 + 4) = h1; }
                    ss += (h0[0] * h0[0] + h0[1] * h0[1]) + (h0[2] * h0[2] + h0[3] * h0[3]) + (h1[0] * h1[0] + h1[1] * h1[1]) + (h1[2] * h1[2] + h1[3] * h1[3]);
                }
                ss += __shfl_xor(ss, 16); ss += __shfl_xor(ss, 32);
                if (fq == 0) RSS[(size_t)row * 16 + u.pn * 4 + wc] = ss;
            }
    }
};

struct Args {
    const float* in[16]; float* out; unsigned char* ws;
};
struct Ctx {
    LAS unsigned char* lds; int tid, lane, wave, G, bid;
    const __attribute__((address_space(4))) Args* ka;
    float* out; unsigned char* ws;
};
#define WSP(T, off) ((T*)(C.ws + (off)))

template <int MODE>
__device__ __forceinline__ void p0_transpose_item(const float* W, int K, int N, bf16_t* WT, const float* kscale, LAS float* scr, int item, int lane) {
    const int nblk = N / 32, kb = item / nblk, nb = item % nblk, k0 = 64 * kb, n0 = 32 * nb;
#pragma unroll 8
    for (int i = 0; i < 32; ++i) { const int kk = 2 * i + (lane >> 5); float v = W[(size_t)(k0 + kk) * N + n0 + (lane & 31)]; if (kscale) v *= kscale[k0 + kk]; scr[kk * 33 + (lane & 31)] = v; }
    asm volatile("s_waitcnt lgkmcnt(0)" ::: "memory");
    const int c = lane & 7;
#pragma unroll
    for (int j = 0; j < 4; ++j) { const int n = (lane >> 3) + 8 * j; const LAS float* s = scr + (8 * c) * 33 + n;
        u32x4 o; o.x = cvt_pk_bf16(s[0 * 33], s[1 * 33]); o.y = cvt_pk_bf16(s[2 * 33], s[3 * 33]); o.z = cvt_pk_bf16(s[4 * 33], s[5 * 33]); o.w = cvt_pk_bf16(s[6 * 33], s[7 * 33]);
        int nn = n0 + n;
        if (MODE == 1) { nn = nn < FH ? (nn >> 7) * 256 + (nn & 127) : ((nn - FH) >> 7) * 256 + 128 + ((nn - FH) & 127); }
        *(u32x4*)(WT + (size_t)nn * K + k0 + 8 * c) = o; }
    asm volatile("s_waitcnt lgkmcnt(0)" ::: "memory");
}
__device__ __forceinline__ void p0_prep(const Ctx& C) {
    LAS float* scr = (LAS float*)(C.lds + C.wave * 16384);
    const int gw = C.bid * 8 + C.wave, NGW = C.G * 8, lane = C.lane;
    constexpr int I_IN = (DM / 64) * (NIN / 32), I_PA = (RV / 64) * (DM / 32), I_PB = (AOUT / 64) * (DM / 32), I_O = (DM / 64) * (DM / 32), I_FI = (DM / 64) * (2 * FH / 32), I_FO = (FH / 64) * (DM / 32);
    constexpr int NITEMS = I_IN + I_PA + I_PB + I_O + I_FI + I_FO;
    for (int it = gw; it < NITEMS; it += NGW) {
        int r = it;
        if (r < I_IN) { p0_transpose_item<0>(C.ka->in[7], DM, NIN, WSP(bf16_t, WS_WIN), nullptr, scr, r, lane); continue; } r -= I_IN;
        if (r < I_PA) { p0_transpose_item<0>(C.ka->in[9], RV, DM, WSP(bf16_t, WS_WPA), nullptr, scr, r, lane); continue; } r -= I_PA;
        if (r < I_PB) { p0_transpose_item<0>(C.ka->in[10], AOUT, DM, WSP(bf16_t, WS_WPB), nullptr, scr, r, lane); continue; } r -= I_PB;
        if (r < I_O) { p0_transpose_item<0>(C.ka->in[11], DM, DM, WSP(bf16_t, WS_WO), nullptr, scr, r, lane); continue; } r -= I_O;
        if (r < I_FI) { p0_transpose_item<1>(C.ka->in[13], DM, 2 * FH, WSP(bf16_t, WS_WFI), C.ka->in[12], scr, r, lane); continue; } r -= I_FI;
        p0_transpose_item<0>(C.ka->in[14], FH, DM, WSP(bf16_t, WS_WFO), nullptr, scr, r, lane);
    }
    const f32x4* g4 = (const f32x4*)C.ka->in[6];
    bf16_t* XN = WSP(bf16_t, WS_XN);
    for (int row = gw; row < MP; row += NGW) {
        u32x2* o8 = (u32x2*)(XN + (size_t)row * DM) + lane;
        if (row >= MR) {
#pragma unroll
            for (int j = 0; j < 4; ++j) o8[64 * j] = (u32x2){0u, 0u};
            continue; }
        const f32x4* xr = (const f32x4*)(row < TP ? C.ka->in[0] + (size_t)row * DM : C.ka->in[1] + (size_t)(row - TP) * DM) + lane;
        f32x4 v[4]; float s = 0.f;
#pragma unroll
        for (int j = 0; j < 4; ++j) { v[j] = xr[64 * j]; s += (v[j][0] * v[j][0] + v[j][1] * v[j][1]) + (v[j][2] * v[j][2] + v[j][3] * v[j][3]); }
        const float rinv = rsqrtf(wave_sum(s) * (1.0f / DM) + EPS);
#pragma unroll
        for (int j = 0; j < 4; ++j) { const f32x4 g = g4[lane + 64 * j]; const f32x4 y = v[j] * rinv * g; o8[64 * j] = (u32x2){cvt_pk_bf16(y[0], y[1]), cvt_pk_bf16(y[2], y[3])}; }
    }
    float* rc = WSP(float, WS_ROPEC); float* rs = WSP(float, WS_ROPES);
    for (int e = (C.bid * 512 + C.tid); e < 4097 * 128; e += C.G * 512) {
        const int p = e >> 7, j = e & 127; const float pos = p < 4096 ? (float)p : (float)PAST;
        const float inv = exp2f(-(float)j * (13.287712379549449f / 128.0f));
        const float ang = pos * inv;
        double r = (double)ang * 0.15915494309189535; r -= floor(r);
        const float fr = (float)r;
        rc[e] = __builtin_amdgcn_cosf(fr); rs[e] = __builtin_amdgcn_sinf(fr);
    }
    { u32x4* pa = (u32x4*)(WSP(bf16_t, WS_APA) + (size_t)MR * RV); const int n1 = (MP - MR) * RV / 8;
      for (int e = C.bid * 512 + C.tid; e < n1; e += C.G * 512) pa[e] = (u32x4){0u, 0u, 0u, 0u};
      u32x4* oa = (u32x4*)(WSP(bf16_t, WS_OA) + (size_t)MR * AOUT); const int n2 = (MP - MR) * AOUT / 8;
      for (int e = C.bid * 512 + C.tid; e < n2; e += C.G * 512) oa[e] = (u32x4){0u, 0u, 0u, 0u}; }
}

__device__ __forceinline__ int wq_next(const Ctx& C, unsigned* ctr) {
    volatile LAS int* slot = (volatile LAS int*)(C.lds + LDS_MISC);
    __syncthreads();
    if (C.tid == 0) *slot = (int)__hip_atomic_fetch_add(ctr, 1u, __ATOMIC_RELAXED, __HIP_MEMORY_SCOPE_AGENT);
    __syncthreads();
    return *slot;
}

__device__ __forceinline__ void ret_chain_task(const Ctx& C, int task) {
    const int bh = task >> 3, sl = task & 7, b = bh >> 2, h = bh & 3, lane = opaque(C.lane), w = C.wave, g = lane >> 4, q4 = (lane & 15) >> 2, p4 = lane & 3;
    const bf16_t* KR = WSP(const bf16_t, WS_KR) + h * 256; const bf16_t* VR = WSP(const bf16_t, WS_VR) + h * 512 + sl * 64;
    bf16_t* ST = WSP(bf16_t, WS_ST);
    LAS unsigned char* KT = C.lds; LAS unsigned char* VT = C.lds + 64 * 528;
    const float cdec = fexp2(128.0f * lg2_gamma(h));
    f32x4 acc[2][4];
#pragma unroll
    for (int i = 0; i < 2; ++i)
#pragma unroll
        for (int j = 0; j < 4; ++j) acc[i][j] = (f32x4){0.f, 0.f, 0.f, 0.f};
#pragma unroll 1
    for (int c = 0; c < 32; ++c) {
        if (c > 0) {
#pragma unroll
            for (int i = 0; i < 2; ++i)
#pragma unroll
                for (int j = 0; j < 4; ++j) acc[i][j] = acc[i][j] * cdec;
        }
#pragma unroll 1
        for (int jh = 0; jh < 2; ++jh) {
            const size_t r0 = (size_t)b * SEQ + c * 128 + jh * 64;
            __syncthreads();
            for (int i = C.tid; i < 64 * 32; i += 512) { const int r = i >> 5, ch = i & 31; *(LAS u32x4*)(KT + r * 528 + ch * 16) = *(const u32x4*)(KR + (r0 + r) * DM + ch * 8); }
            { const int r = C.tid >> 3, ch = C.tid & 7; *(LAS u32x4*)(VT + r * 144 + ch * 16) = *(const u32x4*)(VR + (r0 + r) * RV + ch * 8); }
            __syncthreads();
#pragma unroll
            for (int ks = 0; ks < 2; ++ks) {
                bf16x8 A[2], B[4];
                const int rr = 32 * ks + 8 * g + q4;
#pragma unroll
                for (int md = 0; md < 2; ++md) A[md] = cat8(tr16(KT + rr * 528 + (32 * w + 16 * md) * 2 + 8 * p4), tr16(KT + (rr + 4) * 528 + (32 * w + 16 * md) * 2 + 8 * p4));
#pragma unroll
                for (int nv = 0; nv < 4; ++nv) B[nv] = cat8(tr16(VT + rr * 144 + (16 * nv) * 2 + 8 * p4), tr16(VT + (rr + 4) * 144 + (16 * nv) * 2 + 8 * p4));
#pragma unroll
                for (int md = 0; md < 2; ++md)
#pragma unroll
                    for (int nv = 0; nv < 4; ++nv) acc[md][nv] = mfma16(A[md], B[nv], acc[md][nv]);
            }
        }
        if (c < 31) {
#pragma unroll
            for (int md = 0; md < 2; ++md)
#pragma unroll
                for (int nv = 0; nv < 4; ++nv) { const int v = sl * 64 + 16 * nv + (lane & 15), d = 32 * w + 16 * md + 4 * g;
                    *(u32x2*)(ST + (((size_t)(bh * 31 + c) * 512 + v) * 256 + d)) = (u32x2){cvt_pk_bf16(acc[md][nv][0], acc[md][nv][1]), cvt_pk_bf16(acc[md][nv][2], acc[md][nv][3])}; }
        } else {
            float* SP = C.out + O_SP + (size_t)bh * 256 * 512;
#pragma unroll
            for (int md = 0; md < 2; ++md)
#pragma unroll
                for (int nv = 0; nv < 4; ++nv)
#pragma unroll
                    for (int r = 0; r < 4; ++r) SP[(size_t)(32 * w + 16 * md + 4 * g + r) * 512 + sl * 64 + 16 * nv + (lane & 15)] = acc[md][nv][r];
        }
    }
}

__device__ __forceinline__ void attn_unit(const Ctx& C, int uid) {
    const int b = uid / 384; int rem = uid % 384; const int grp = rem >> 7; rem &= 127; const int head = rem >> 5, sb = rem & 31;
    const int dil = 1 << (2 * grp), nblk = 32 >> (2 * grp), r = sb / nblk, nb = sb % nblk;
    const int col0 = grp * 512 + head * 128, lane = opaque(C.lane), w = C.wave, g = lane >> 4, q4 = (lane & 15) >> 2, p4 = lane & 3;
    const bf16_t* QA = WSP(const bf16_t, WS_QA); const bf16_t* KA = WSP(const bf16_t, WS_KA); const bf16_t* VA = WSP(const bf16_t, WS_VA);
    LAS unsigned char* KT = C.lds; LAS unsigned char* VT = C.lds + 256 * 272;
    __syncthreads();
    for (int i = C.tid; i < 256 * 16; i += 512) { const int jj = i >> 4, ch = i & 15; int n = 128 * (nb - 1) + jj; n = n < 0 ? 0 : n;
        const size_t row = (size_t)b * SEQ + (size_t)n * dil + r;
        *(LAS u32x4*)(KT + jj * 272 + ch * 16) = *(const u32x4*)(KA + row * AW + col0 + ch * 8);
        *(LAS u32x4*)(VT + jj * 272 + ch * 16) = *(const u32x4*)(VA + row * AW + col0 + ch * 8); }
    const int qi = 16 * w + (lane & 15); const size_t qrow = (size_t)b * SEQ + (size_t)(128 * nb + qi) * dil + r;
    bf16x8 qf[4];
#pragma unroll
    for (int ks = 0; ks < 4; ++ks) qf[ks] = *(const bf16x8*)(QA + qrow * AW + col0 + 32 * ks + 8 * g);
    __syncthreads();
    f32x4 s[16];
#pragma unroll
    for (int kt = 0; kt < 16; ++kt) { s[kt] = (f32x4){0.f, 0.f, 0.f, 0.f};
#pragma unroll
        for (int ks = 0; ks < 4; ++ks) { const bf16x8 a = *(const LAS bf16x8*)(KT + (16 * kt + (lane & 15)) * 272 + (32 * ks + 8 * g) * 2); s[kt] = mfma16(a, qf[ks], s[kt]); } }
    float mx = -INFINITY;
#pragma unroll
    for (int kt = 0; kt < 16; ++kt)
#pragma unroll
        for (int rg = 0; rg < 4; ++rg) { const int key = 16 * kt + 4 * g + rg; const bool ok = key >= qi && key <= qi + 128 && (nb > 0 || key >= 128);
            s[kt][rg] = ok ? s[kt][rg] : -INFINITY; mx = fmaxf(mx, s[kt][rg]); }
    mx = fmaxf(mx, __shfl_xor(mx, 16)); mx = fmaxf(mx, __shfl_xor(mx, 32));
    float l = 0.f;
#pragma unroll
    for (int kt = 0; kt < 16; ++kt)
#pragma unroll
        for (int rg = 0; rg < 4; ++rg) { const float p = fexp2(s[kt][rg] - mx); s[kt][rg] = p; l += p; }
    l += __shfl_xor(l, 16); l += __shfl_xor(l, 32);
    f32x4 o[8];
#pragma unroll
    for (int ne = 0; ne < 8; ++ne) o[ne] = (f32x4){0.f, 0.f, 0.f, 0.f};
#pragma unroll
    for (int kp = 0; kp < 8; ++kp) {
        bf16x8 pf; { const u32x4 wv = pack8(s[2 * kp], s[2 * kp + 1]); pf = __builtin_bit_cast(bf16x8, wv); }
        const int r0 = 32 * kp + 4 * g + q4;
#pragma unroll
        for (int ne = 0; ne < 8; ++ne) { const bf16x8 a = cat8(tr16(VT + r0 * 272 + (16 * ne) * 2 + 8 * p4), tr16(VT + (r0 + 16) * 272 + (16 * ne) * 2 + 8 * p4)); o[ne] = mfma16(a, pf, o[ne]); }
    }
    const float linv = frcp(l);
    bf16_t* OG = WSP(bf16_t, WS_OG) + qrow * AW + col0 + 4 * g;
#pragma unroll
    for (int ne = 0; ne < 8; ++ne) { const f32x4 v = o[ne] * linv; *(u32x2*)(OG + 16 * ne) = (u32x2){cvt_pk_bf16(v[0], v[1]), cvt_pk_bf16(v[2], v[3])}; }
    if (g == 0) WSP(float, WS_LSE)[qrow * 12 + grp * 4 + head] = (mx + flog2(l)) * LN2;
}

__device__ __forceinline__ void samp_state_task(const Ctx& C, int task) {
    const int bs = task >> 3, h = (task >> 1) & 3, vh = task & 1, tid = opaque(C.tid), cg4 = tid & 63, rg = tid >> 6;
    LAS float* qs = (LAS float*)C.lds; LAS float* ks = qs + 256; LAS float* red = ks + 256;
    const size_t row = TP + bs;
    __syncthreads();
    if (tid < 256) { qs[tid] = bf2f(WSP(const bf16_t, WS_QR)[row * DM + h * 256 + tid]); ks[tid] = bf2f(WSP(const bf16_t, WS_KR)[row * DM + h * 256 + tid]); }
    const bf16_t* vp = WSP(const bf16_t, WS_VR) + row * RV + h * 512 + vh * 256 + cg4 * 4;
    const u32x2 vw = *(const u32x2*)vp; const f32x4 vv = (f32x4){bflo(vw.x), bfhi(vw.x), bflo(vw.y), bfhi(vw.y)};
    const float gam = 1.0f - exp2f(-(float)(5 + h));
    const size_t sbase = ((size_t)(bs * 4 + h) * 256) * 512 + vh * 256 + cg4 * 4;
    const float* S0 = C.ka->in[2] + sbase; float* S1 = C.out + O_SS + sbase;
    __syncthreads();
    f32x4 oacc = (f32x4){0.f, 0.f, 0.f, 0.f};
#pragma unroll 4
    for (int i = 0; i < 32; ++i) { const int d = rg + 8 * i; const f32x4 s0 = *(const f32x4*)(S0 + (size_t)d * 512); const f32x4 sn = s0 * gam + vv * ks[d]; *(f32x4*)(S1 + (size_t)d * 512) = sn; oacc += sn * qs[d]; }
    *(LAS f32x4*)(red + rg * 256 + cg4 * 4) = oacc;
    __syncthreads();
    if (tid < 256) { float s = 0.f;
#pragma unroll
        for (int k = 0; k < 8; ++k) s += red[k * 256 + tid];
        WSP(float, WS_OS)[(size_t)(bs * 4 + h) * 512 + vh * 256 + tid] = s; }
}

__device__ __forceinline__ void samp_attn_wave(const Ctx& C, int wt) {
    const int bs = wt / 12, grp = (wt % 12) >> 2, head = wt & 3, lane = opaque(C.lane);
    const int dil = 1 << (2 * grp), Wb = 128 * dil; const size_t row = TP + bs; const int col0 = grp * 512 + head * 128;
    const float *c3 = C.ka->in[3], *c4 = C.ka->in[4], *c5 = C.ka->in[5];
    asm volatile("" : "+s"(c3), "+s"(c4), "+s"(c5));
    const float* cache = (grp == 0 ? c3 : grp == 1 ? c4 : c5) + (size_t)bs * Wb * 1024 + head * 128 + 2 * lane;
    LAS float* sc = (LAS float*)(C.lds + 65536 + C.wave * 1024);
    const unsigned qw = *(const unsigned*)(WSP(const bf16_t, WS_QA) + row * AW + col0 + 2 * lane); const float q0 = bflo(qw), q1 = bfhi(qw);
    const unsigned kw = *(const unsigned*)(WSP(const bf16_t, WS_KA) + row * AW + col0 + 2 * lane);
    const unsigned vw = *(const unsigned*)(WSP(const bf16_t, WS_VA) + row * AW + col0 + 2 * lane);
    { const float d = wave_sum(q0 * bflo(kw) + q1 * bfhi(kw)); if (lane == 0) sc[0] = d; }
    for (int m0 = 1; m0 <= 128; m0 += 8) {
        float d[8];
#pragma unroll
        for (int u = 0; u < 8; ++u) { const f32x2 kk = *(const f32x2*)(cache + (size_t)(Wb - dil * (m0 + u)) * 1024); d[u] = q0 * kk[0] + q1 * kk[1]; }
#pragma unroll
        for (int u = 0; u < 8; ++u) { const float t = wave_sum(d[u]); if (lane == 0) sc[m0 + u] = t; }
    }
    asm volatile("s_waitcnt lgkmcnt(0)" ::: "memory");
    float s0 = sc[lane], s1 = sc[lane + 64], s2 = lane == 0 ? sc[128] : -INFINITY;
    float mx = fmaxf(fmaxf(s0, s1), s2);
#pragma unroll
    for (int o = 1; o < 64; o <<= 1) mx = fmaxf(mx, __shfl_xor(mx, o));
    const float p0 = fexp2(s0 - mx), p1 = fexp2(s1 - mx), p2 = lane == 0 ? fexp2(s2 - mx) : 0.f;
    const float l = wave_sum(p0 + p1 + p2);
    sc[lane] = p0; sc[lane + 64] = p1; if (lane == 0) sc[128] = p2;
    asm volatile("s_waitcnt lgkmcnt(0)" ::: "memory");
    float o0 = sc[0] * bflo(vw), o1 = sc[0] * bfhi(vw);
    for (int m0 = 1; m0 <= 128; m0 += 8) {
        f32x2 vv[8];
#pragma unroll
        for (int u = 0; u < 8; ++u) vv[u] = *(const f32x2*)(cache + (size_t)(Wb - dil * (m0 + u)) * 1024 + 512);
#pragma unroll
        for (int u = 0; u < 8; ++u) { const float p = sc[m0 + u]; o0 += p * vv[u][0]; o1 += p * vv[u][1]; }
    }
    const float linv = frcp(l);
    *(unsigned*)(WSP(bf16_t, WS_OG) + row * AW + col0 + 2 * lane) = cvt_pk_bf16(o0 * linv, o1 * linv);
    if (lane == 0) WSP(float, WS_LSE)[row * 12 + grp * 4 + head] = (mx + flog2(l)) * LN2;
}

__device__ __forceinline__ void ret_out_task(const Ctx& C, int task) {
    const int bh = task >> 5, c = task & 31, b = bh >> 2, h = bh & 3, lane = opaque(C.lane), w = C.wave, g = lane >> 4, q4 = (lane & 15) >> 2, p4 = lane & 3, l15 = lane & 15;
    const size_t r0 = (size_t)b * SEQ + c * 128;
    const bf16_t* QR = WSP(const bf16_t, WS_QR) + r0 * DM + h * 256; const bf16_t* KR = WSP(const bf16_t, WS_KR) + r0 * DM + h * 256;
    const bf16_t* VR = WSP(const bf16_t, WS_VR) + r0 * RV + h * 512;
    LAS unsigned char* QT = C.lds;
    LAS unsigned char* PT = C.lds + 18432;
    LAS unsigned char* XT = C.lds + 53248;
    const float ginv = fexp2(-128.0f * lg2_gamma(h));
    {
        f32x4 a1[8];
#pragma unroll
        for (int jt = 0; jt < 8; ++jt) a1[jt] = (f32x4){0.f, 0.f, 0.f, 0.f};
#pragma unroll 1
        for (int dt = 0; dt < 4; ++dt) {
            __syncthreads();
            for (int i = C.tid; i < 128 * 8; i += 512) { const int r = i >> 3, ch = i & 7;
                *(LAS u32x4*)(QT + r * 144 + ch * 16) = *(const u32x4*)(QR + (size_t)r * DM + dt * 64 + ch * 8);
                *(LAS u32x4*)(XT + r * 144 + ch * 16) = *(const u32x4*)(KR + (size_t)r * DM + dt * 64 + ch * 8); }
            __syncthreads();
#pragma unroll
            for (int ks = 0; ks < 2; ++ks) {
                const bf16x8 bq = *(const LAS bf16x8*)(QT + (16 * w + l15) * 144 + (32 * ks + 8 * g) * 2);
#pragma unroll
                for (int jt = 0; jt < 8; ++jt) if (jt <= w) { const bf16x8 ak = *(const LAS bf16x8*)(XT + (16 * jt + l15) * 144 + (32 * ks + 8 * g) * 2); a1[jt] = mfma16(ak, bq, a1[jt]); }
            }
        }
        const int i = 16 * w + l15;
#pragma unroll
        for (int jt = 0; jt < 8; ++jt) { f32x4 v = a1[jt] * ginv;
#pragma unroll
            for (int rg = 0; rg < 4; ++rg) { const int j = 16 * jt + 4 * g + rg; if (jt > w || j > i) v[rg] = 0.f; }
            *(LAS u32x2*)(PT + i * 272 + (16 * jt + 4 * g) * 2) = (u32x2){cvt_pk_bf16(v[0], v[1]), cvt_pk_bf16(v[2], v[3])}; }
    }
    f32x4 a2[8][4];
#pragma unroll
    for (int it = 0; it < 8; ++it)
#pragma unroll
        for (int vt = 0; vt < 4; ++vt) a2[it][vt] = (f32x4){0.f, 0.f, 0.f, 0.f};
    if (c > 0) {
        const bf16_t* STc = WSP(const bf16_t, WS_ST) + (size_t)(bh * 31 + (c - 1)) * 512 * 256;
#pragma unroll 1
        for (int dt = 0; dt < 4; ++dt) {
            __syncthreads();
            for (int i = C.tid; i < 128 * 8; i += 512) { const int r = i >> 3, ch = i & 7; *(LAS u32x4*)(QT + r * 144 + ch * 16) = *(const u32x4*)(QR + (size_t)r * DM + dt * 64 + ch * 8); }
            for (int i = C.tid; i < 512 * 8; i += 512) { const int r = i >> 3, ch = i & 7; *(LAS u32x4*)(XT + r * 144 + ch * 16) = *(const u32x4*)(STc + (size_t)r * 256 + dt * 64 + ch * 8); }
            __syncthreads();
#pragma unroll
            for (int ks = 0; ks < 2; ++ks) {
                bf16x8 A[4];
#pragma unroll
                for (int vt = 0; vt < 4; ++vt) A[vt] = *(const LAS bf16x8*)(XT + (64 * w + 16 * vt + l15) * 144 + (32 * ks + 8 * g) * 2);
#pragma unroll
                for (int it = 0; it < 8; ++it) { const bf16x8 B = *(const LAS bf16x8*)(QT + (16 * it + l15) * 144 + (32 * ks + 8 * g) * 2);
#pragma unroll
                    for (int vt = 0; vt < 4; ++vt) a2[it][vt] = mfma16(A[vt], B, a2[it][vt]); }
            }
        }
    }
#pragma unroll 1
    for (int jt2 = 0; jt2 < 2; ++jt2) {
        __syncthreads();
        for (int i = C.tid; i < 64 * 64; i += 512) { const int r = i >> 6, ch = i & 63; *(LAS u32x4*)(XT + r * 1040 + ch * 16) = *(const u32x4*)(VR + (size_t)(jt2 * 64 + r) * RV + ch * 8); }
        __syncthreads();
#pragma unroll
        for (int ks = 0; ks < 2; ++ks) {
            bf16x8 A[4];
            const int rr = 32 * ks + 8 * g + q4;
#pragma unroll
            for (int vt = 0; vt < 4; ++vt) A[vt] = cat8(tr16(XT + rr * 1040 + (64 * w + 16 * vt) * 2 + 8 * p4), tr16(XT + (rr + 4) * 1040 + (64 * w + 16 * vt) * 2 + 8 * p4));
#pragma unroll
            for (int it = 0; it < 8; ++it) { const bf16x8 B = *(const LAS bf16x8*)(PT + (16 * it + l15) * 272 + (jt2 * 64 + 32 * ks + 8 * g) * 2);
#pragma unroll
                for (int vt = 0; vt < 4; ++vt) a2[it][vt] = mfma16(A[vt], B, a2[it][vt]); }
        }
    }
    __syncthreads();
    LAS float* red = (LAS float*)C.lds;
#pragma unroll
    for (int it = 0; it < 8; ++it) { float s = 0.f;
#pragma unroll
        for (int vt = 0; vt < 4; ++vt) s += (a2[it][vt][0] * a2[it][vt][0] + a2[it][vt][1] * a2[it][vt][1]) + (a2[it][vt][2] * a2[it][vt][2] + a2[it][vt][3] * a2[it][vt][3]);
        s += __shfl_xor(s, 16); s += __shfl_xor(s, 32);
        if (g == 0) red[w * 128 + 16 * it + l15] = s; }
    __syncthreads();
    const float* gn = C.ka->in[8] + h * 512; const bf16_t* GS = WSP(const bf16_t, WS_GS) + r0 * RV + h * 512; bf16_t* APA = WSP(bf16_t, WS_APA) + r0 * RV + h * 512;
#pragma unroll
    for (int it = 0; it < 8; ++it) { const int i = 16 * it + l15; float s = 0.f;
#pragma unroll
        for (int k = 0; k < 8; ++k) s += red[k * 128 + i];
        const float rinv = rsqrtf(s * (1.0f / 512.0f) + EPS);
#pragma unroll
        for (int vt = 0; vt < 4; ++vt) { const int v = 64 * w + 16 * vt + 4 * g; const f32x4 gg = *(const f32x4*)(gn + v); const u32x2 gw = *(const u32x2*)(GS + (size_t)i * RV + v);
            const f32x4 y = a2[it][vt] * rinv * gg; *(u32x2*)(APA + (size_t)i * RV + v) = (u32x2){cvt_pk_bf16(y[0] * bflo(gw.x), y[1] * bfhi(gw.x)), cvt_pk_bf16(y[2] * bflo(gw.y), y[3] * bfhi(gw.y))}; }
        asm volatile("" ::: "memory");
    }
}
__device__ __forceinline__ void combine_row(const Ctx& C, int row) {
    const int lane = opaque(C.lane), slot = lane >> 4;
    const float* ls = WSP(const float, WS_LSE) + (size_t)row * 12 + slot; const float l0 = ls[0], l1 = ls[4], l2 = ls[8];
    const float mx = fmaxf(l0, fmaxf(l1, l2)); const float e0 = fexp2((l0 - mx) * 1.4426950408889634f), e1 = fexp2((l1 - mx) * 1.4426950408889634f), e2 = fexp2((l2 - mx) * 1.4426950408889634f);
    const float inv = frcp(e0 + e1 + e2);
    const bf16_t* og = WSP(const bf16_t, WS_OG) + (size_t)row * AW + lane * 8;
    f32x4 a0, a1, b0, b1, c0, c1; unpack8(*(const u32x4*)og, a0, a1); unpack8(*(const u32x4*)(og + 512), b0, b1); unpack8(*(const u32x4*)(og + 1024), c0, c1);
    const f32x4 r0 = (a0 * e0 + b0 * e1 + c0 * e2) * inv, r1 = (a1 * e0 + b1 * e1 + c1 * e2) * inv;
    *(u32x4*)(WSP(bf16_t, WS_OA) + (size_t)row * AOUT + lane * 8) = pack8(r0, r1);
}
__device__ __forceinline__ void samp_fin_wave(const Ctx& C, int wt) {
    const int bs = wt >> 2, h = wt & 3, lane = opaque(C.lane); const size_t row = TP + bs;
    const float* os = WSP(const float, WS_OS) + (size_t)wt * 512 + lane * 8;
    const f32x4 x0 = *(const f32x4*)os, x1 = *(const f32x4*)(os + 4);
    const float ss = wave_sum((x0[0] * x0[0] + x0[1] * x0[1]) + (x0[2] * x0[2] + x0[3] * x0[3]) + (x1[0] * x1[0] + x1[1] * x1[1]) + (x1[2] * x1[2] + x1[3] * x1[3]));
    const float rinv = rsqrtf(ss * (1.0f / 512.0f) + EPS);
    const float* gn = C.ka->in[8] + h * 512 + lane * 8; const f32x4 g0 = *(const f32x4*)gn, g1 = *(const f32x4*)(gn + 4);
    f32x4 s0, s1; unpack8(*(const u32x4*)(WSP(const bf16_t, WS_GS) + row * RV + h * 512 + lane * 8), s0, s1);
    *(u32x4*)(WSP(bf16_t, WS_APA) + row * RV + h * 512 + lane * 8) = pack8(x0 * rinv * g0 * s0, x1 * rinv * g1 * s1);
}

__device__ __forceinline__ void final_norm(const Ctx& C) {
    const int gw = C.bid * 8 + C.wave, NGW = C.G * 8, lane = C.lane;
    const f32x4* g4 = (const f32x4*)C.ka->in[15]; const float* RSS = WSP(const float, WS_RSS2);
    for (int row = gw; row < MR; row += NGW) {
        const f32x4* rp = (const f32x4*)(RSS + (size_t)row * 16); const f32x4 r0 = rp[0], r1 = rp[1], r2 = rp[2], r3 = rp[3];
        const float ssum = ((r0[0] + r0[1]) + (r0[2] + r0[3])) + ((r1[0] + r1[1]) + (r1[2] + r1[3])) + ((r2[0] + r2[1]) + (r2[2] + r2[3])) + ((r3[0] + r3[1]) + (r3[2] + r3[3]));
        const float rinv = rsqrtf(ssum * (1.0f / DM) + EPS);
        f32x4* y = (f32x4*)(C.out + (size_t)row * DM) + lane;
#pragma unroll
        for (int j = 0; j < 4; ++j) y[64 * j] = y[64 * j] * rinv * g4[lane + 64 * j];
    }
}


#define XB_TMO      128
#define XB_XCNT(j)  (256  + 64 * (j))
#define XB_XSUB(j)  (1280 + 64 * (j))
#define XB_XGEN(j)  (2304 + 64 * (j))
#define XB_TOP      3328
#define XB_TOPGEN   3392
#define XCD_BAR_WORDS 3456
#define XB_SPIN_CAP (1u << 18)
__device__ __forceinline__ unsigned xb_ld(unsigned* p)              { return __hip_atomic_load(p, __ATOMIC_RELAXED, __HIP_MEMORY_SCOPE_AGENT); }
__device__ __forceinline__ unsigned xb_add(unsigned* p, unsigned v) { return __hip_atomic_fetch_add(p, v, __ATOMIC_RELAXED, __HIP_MEMORY_SCOPE_AGENT); }
__device__ __forceinline__ unsigned xb_xcc_id() { return (unsigned)__builtin_amdgcn_s_getreg((3 << 11) | 20) & 0xFu; }
#define XB_SPIN(cond, bar) do { unsigned _sp = 0; while (cond) { __builtin_amdgcn_s_sleep(1); \
    if ((++_sp & 255u) == 0u) { if (xb_ld(&(bar)[XB_TMO])) break; if (_sp > XB_SPIN_CAP) { atomicAdd(&(bar)[XB_TMO], 1u); break; } } } } while (0)
struct XcdBarrier { unsigned* bar; unsigned x; volatile LAS unsigned* st; };
__device__ __forceinline__ XcdBarrier xcd_barrier_post(unsigned* bar, volatile LAS unsigned* st) {
    XcdBarrier b; b.bar = bar; b.x = xb_xcc_id(); b.st = st;
    if (threadIdx.x == 0) (void)xb_add(&bar[XB_XCNT(b.x)], 1u);
    return b;
}
__device__ __forceinline__ void xcd_barrier_complete(unsigned* bar, unsigned x, unsigned& nloc, unsigned& nx) {
    const unsigned G = gridDim.x * gridDim.y * gridDim.z;
    unsigned sum, cnt, mine, sp = 0u;
    for (;;) {
        sum = 0u; cnt = 0u; mine = 0u;
#pragma unroll
        for (unsigned j = 0; j < 16; ++j) { const unsigned c = xb_ld(&bar[XB_XCNT(j)]); sum += c; cnt += (c > 0u) ? 1u : 0u; mine = (j == x) ? c : mine; }
        if (sum == G) break;
        __builtin_amdgcn_s_sleep(1);
        if ((++sp & 255u) == 0u) { if (xb_ld(&bar[XB_TMO])) break; if (sp > XB_SPIN_CAP) { atomicAdd(&bar[XB_TMO], 1u); break; } }
    }
    nloc = mine > 0u ? mine : 1u; nx = cnt > 0u ? cnt : 1u;
}
__device__ __forceinline__ void xcd_barrier(const XcdBarrier& b) {
    asm volatile("s_waitcnt vmcnt(0)" ::: "memory");
    __syncthreads();
    if (threadIdx.x == 0) {
        unsigned* bar = b.bar;
        __builtin_amdgcn_s_waitcnt(0);
        unsigned nloc = b.st[0], nx = b.st[1];
        if (nloc == 0u) { xcd_barrier_complete(bar, b.x, nloc, nx); b.st[0] = nloc; b.st[1] = nx; }
        const unsigned old = xb_add(&bar[XB_XSUB(b.x)], 1u);
        const unsigned gen = old / nloc;
        if (old + 1u == (gen + 1u) * nloc) {
            __builtin_amdgcn_fence(__ATOMIC_RELEASE, "agent");
            asm volatile("s_waitcnt vmcnt(0)" ::: "memory");
            const unsigned og = xb_add(&bar[XB_TOP], 1u);
            const unsigned tg = og / nx;
            if (og + 1u == (tg + 1u) * nx) xb_add(&bar[XB_TOPGEN], 1u);
            else XB_SPIN(xb_ld(&bar[XB_TOPGEN]) == tg, bar);
            __builtin_amdgcn_fence(__ATOMIC_ACQUIRE, "agent");
            xb_add(&bar[XB_XGEN(b.x)], 1u);
            asm volatile("s_waitcnt vmcnt(0)" ::: "memory");
        } else {
            XB_SPIN(xb_ld(&bar[XB_XGEN(b.x)]) == gen, bar);
            __builtin_amdgcn_fence(__ATOMIC_ACQUIRE, "agent");
            asm volatile("s_waitcnt vmcnt(0)" ::: "memory");
        }
    }
    __syncthreads();
}

template <int PH_LO, int PH_HI>
__global__ void __launch_bounds__(512, 2) mk_fwd(Args args) {
    extern __shared__ __attribute__((aligned(16))) unsigned char lds_raw[];
    Ctx C; C.lds = (LAS unsigned char*)lds_raw; C.tid = threadIdx.x; C.lane = C.tid & 63; C.wave = __builtin_amdgcn_readfirstlane(C.tid >> 6); C.G = gridDim.x; C.bid = blockIdx.x;
    C.ka = (const __attribute__((address_space(4))) Args*)__builtin_amdgcn_kernarg_segment_ptr();
    C.out = args.out; C.ws = args.ws;
    unsigned* ctl = (unsigned*)(C.ws + WS_CTL);
    constexpr int lo = PH_LO, hi = PH_HI;
#if MK_FUSED
    cg::grid_group grid = cg::this_grid();
    if (C.tid < 8) ((LAS unsigned*)(C.lds + LDS_MISC))[C.tid] = 0u;
    __syncthreads();
    const XcdBarrier xbar = xcd_barrier_post(ctl + CW_BAR, (volatile LAS unsigned*)(C.lds + LDS_MISC + 16));
#define SEAM(k) do { if constexpr (lo <= (k) && (k) + 1 < hi) { if constexpr ((k) == 0) grid.sync(); else xcd_barrier(xbar); } } while (0)
#else
#define SEAM(k) do { } while (0)
#endif
#define IN(k) constexpr (lo <= (k) && (k) < hi)
    if IN(0) { p0_prep(C); }
    SEAM(0);
    if IN(1) {
        pg8::Gemm g{WSP(const bf16_t, WS_XN), WSP(const bf16_t, WS_WIN), MP, NIN, DM}; pg8::StaticOrder S; S.init(MP, NIN, C.G, C.bid);
        EpiIn E{C.ws, WSP(const float, WS_ROPEC), WSP(const float, WS_ROPES), C.out};
        pg8::gemm_phase<EpiIn, pg8::StaticOrder, true, true>(C.lds, g, S, E);
    }
    SEAM(1);
    if IN(2) {
        for (;;) {
            const int id = wq_next(C, ctl + CW_Q2);
            if (id < 128) ret_chain_task(C, id);
            else if (id < 128 + 1536) attn_unit(C, id - 128);
            else if (id < 1664 + 256) samp_state_task(C, id - 1664);
            else if (id < 1920 + 48) samp_attn_wave(C, (id - 1920) * 8 + C.wave);
            else break;
        }
    }
    SEAM(2);
    if IN(3) {
        for (;;) {
            const int id = wq_next(C, ctl + CW_Q3);
            if (id < 512) ret_out_task(C, id);
            else if (id < 512 + 65) { const int r0 = (id - 512) * 256 + C.wave * 32; for (int r = 0; r < 32; ++r) if (r0 + r < MR) combine_row(C, r0 + r); }
            else if (id < 577 + 16) samp_fin_wave(C, (id - 577) * 8 + C.wave);
            else break;
        }
    }
    SEAM(3);
    if IN(4) {
        pg8::Gemm g{WSP(const bf16_t, WS_APA), WSP(const bf16_t, WS_WPA), MP, DM, RV}; pg8::StaticOrder S; S.init(MP, DM, C.G, C.bid);
        EpiPa E{WSP(const bf16_t, WS_SGA), WSP(float, WS_P)};
        pg8::gemm_phase<EpiPa, pg8::StaticOrder, true, true>(C.lds, g, S, E);
    }
    if IN(5) {
        pg8::Gemm g{WSP(const bf16_t, WS_OA), WSP(const bf16_t, WS_WPB), MP, DM, AOUT}; pg8::StaticOrder S; S.init(MP, DM, C.G, C.bid);
        EpiPb E{WSP(const bf16_t, WS_SGB), WSP(const float, WS_P), WSP(bf16_t, WS_MERGED)};
        pg8::gemm_phase<EpiPb, pg8::StaticOrder, true, true>(C.lds, g, S, E);
    }
    SEAM(5);
    if IN(6) {
        pg8::Gemm g{WSP(const bf16_t, WS_MERGED), WSP(const bf16_t, WS_WO), MP, DM, DM}; pg8::StaticOrder S; S.init(MP, DM, C.G, C.bid);
        EpiO E{C.ka->in[0], C.ka->in[1], WSP(float, WS_H), WSP(bf16_t, WS_HB), WSP(float, WS_RSS1)};
        pg8::gemm_phase<EpiO, pg8::StaticOrder, true, true>(C.lds, g, S, E);
    }
    SEAM(6);
    if IN(7) {
        pg8::Gemm g{WSP(const bf16_t, WS_HB), WSP(const bf16_t, WS_WFI), MP, 2 * FH, DM}; pg8::StaticOrder S; S.init(MP, 2 * FH, C.G, C.bid);
        EpiFi E{WSP(const float, WS_RSS1), WSP(bf16_t, WS_HID)};
        pg8::gemm_phase<EpiFi, pg8::StaticOrder, true, true>(C.lds, g, S, E);
    }
    SEAM(7);
    if IN(8) {
        pg8::Gemm g{WSP(const bf16_t, WS_HID), WSP(const bf16_t, WS_WFO), MP, DM, FH}; pg8::StaticOrder S; S.init(MP, DM, C.G, C.bid);
        EpiFo E{WSP(const float, WS_H), C.out, WSP(float, WS_RSS2)};
        pg8::gemm_phase<EpiFo, pg8::StaticOrder, true, true>(C.lds, g, S, E);
    }
    SEAM(8);
    if IN(9) final_norm(C);
#undef IN
#undef SEAM
}

template <int LO, int HI> static void launch_range(int grid, const Args& a, hipStream_t stream) {
    static bool attr = false;
    if (!attr) { (void)hipFuncSetAttribute((const void*)mk_fwd<LO, HI>, hipFuncAttributeMaxDynamicSharedMemorySize, LDS_BYTES); attr = true; }
    hipLaunchKernelGGL((mk_fwd<LO, HI>), dim3(grid), dim3(512), LDS_BYTES, stream, a);
}
extern "C" void kernel_launch(void* const* d_in, const int* in_sizes, int n_in, void* d_out, int out_size, void* d_ws, size_t ws_size, hipStream_t stream) {
    static int grid = 0;
    if (grid == 0) {
        if (n_in != 16 || out_size != (int)O_END || ws_size < WS_END) { fprintf(stderr, "kernel_launch: unexpected shapes (n_in %d out %d ws %zu)\n", n_in, out_size, ws_size); grid = -1; return; }
        int dev = 0, cus = 0;
        (void)hipGetDevice(&dev); (void)hipDeviceGetAttribute(&cus, hipDeviceAttributeMultiprocessorCount, dev);
#if MK_FUSED
        int per_cu = 0;
        (void)hipFuncSetAttribute((const void*)mk_fwd<0, 10>, hipFuncAttributeMaxDynamicSharedMemorySize, LDS_BYTES);
        (void)hipOccupancyMaxActiveBlocksPerMultiprocessor(&per_cu, (const void*)mk_fwd<0, 10>, 512, LDS_BYTES);
        if (per_cu < 1) { fprintf(stderr, "kernel_launch: occupancy query says %d blocks per CU\n", per_cu); grid = -1; return; }
#endif
        (void)hipGetLastError();
        grid = cus;
    }
    if (grid < 0) return;
    (void)hipMemsetAsync((char*)d_ws + WS_CTL, 0, CTL_BYTES, stream);
    Args a{};
    for (int i = 0; i < 16; ++i) a.in[i] = (const float*)d_in[i];
    a.out = (float*)d_out; a.ws = (unsigned char*)d_ws;
#if MK_FUSED
    void* kargs[] = {&a};
    hipError_t e = hipLaunchCooperativeKernel((const void*)mk_fwd<0, 10>, dim3(grid), dim3(512), kargs, LDS_BYTES, stream);
    if (e != hipSuccess) fprintf(stderr, "cooperative launch failed: %s (grid %d)\n", hipGetErrorString(e), grid);
#else
    launch_range<0, 1>(grid, a, stream); launch_range<1, 2>(grid, a, stream); launch_range<2, 3>(grid, a, stream); launch_range<3, 4>(grid, a, stream);
    launch_range<4, 6>(grid, a, stream); launch_range<6, 7>(grid, a, stream); launch_range<7, 8>(grid, a, stream); launch_range<8, 9>(grid, a, stream); launch_range<9, 10>(grid, a, stream);
#endif
}
```

```cpp
#include <hip/hip_runtime.h>
#include <hip/hip_cooperative_groups.h>
#include <cstdio>
#include <cstdint>
namespace cg = cooperative_groups;

#ifndef MK_FUSED
#define MK_FUSED 1
#endif

#define LAS __attribute__((address_space(3)))
typedef unsigned short bf16_t;
typedef short bf16x8 __attribute__((ext_vector_type(8)));
typedef short s16x4 __attribute__((ext_vector_type(4)));
typedef float f32x4 __attribute__((ext_vector_type(4)));
typedef float f32x2 __attribute__((ext_vector_type(2)));
typedef unsigned u32x4 __attribute__((ext_vector_type(4)));
typedef unsigned u32x2 __attribute__((ext_vector_type(2)));

constexpr int DM = 1024, SEQ = 4096, NBATCH = 4, TP = NBATCH * SEQ  , NSAMP = 32, MR = TP + NSAMP  , MP = 16640  ;
constexpr int NIN = 12800, RV = 2048, AW = 1536, AOUT = 512, FH = 2816;
constexpr int PAST = 16384;
constexpr float EPS = 1e-6f;
constexpr size_t O_Y = 0, O_SP = 16809984, O_SS = 18907136, O_KV0P = 35684352, O_KV0S = 36208640, O_KV1P = 36241408, O_KV1S = 38338560, O_KV2P = 38371328, O_KV2S = 46759936, O_END = 46792704;
__device__ __forceinline__ float lg2_gamma(int h) { return h == 0 ? -0.04580368961312479f : h == 1 ? -0.02272007650008353f : h == 2 ? -0.011315313227834146f : -0.005646563141142063f; }
constexpr float QSCALE_A = 0.12751743082459868f;
constexpr float LN2 = 0.6931471805599453f;

constexpr size_t MiB = 1u << 20;
constexpr size_t al(size_t x) { return (x + MiB - 1) / MiB * MiB; }
constexpr size_t WS_CTL = 0, CTL_BYTES = MiB;
constexpr size_t WS_ROPEC = WS_CTL + CTL_BYTES, ROPE_BYTES = al((size_t)4097 * 128 * 4);
constexpr size_t WS_ROPES = WS_ROPEC + ROPE_BYTES;
constexpr size_t WS_WIN = WS_ROPES + ROPE_BYTES;
constexpr size_t WS_WPA = WS_WIN + al((size_t)NIN * DM * 2);
constexpr size_t WS_WPB = WS_WPA + al((size_t)DM * RV * 2);
constexpr size_t WS_WO = WS_WPB + al((size_t)DM * AOUT * 2);
constexpr size_t WS_WFI = WS_WO + al((size_t)DM * DM * 2);
constexpr size_t WS_WFO = WS_WFI + al((size_t)2 * FH * DM * 2);
constexpr size_t WS_XN = WS_WFO + al((size_t)DM * FH * 2);
constexpr size_t WS_QR = WS_XN + al((size_t)MP * DM * 2);
constexpr size_t WS_KR = WS_QR + (size_t)MP * DM * 2;
constexpr size_t WS_VR = WS_KR + al((size_t)MP * DM * 2);
constexpr size_t WS_GS = WS_VR + al((size_t)MP * RV * 2);
constexpr size_t WS_QA = WS_GS + al((size_t)MP * RV * 2);
constexpr size_t WS_KA = WS_QA + al((size_t)MP * AW * 2);
constexpr size_t WS_VA = WS_KA + al((size_t)MP * AW * 2);
constexpr size_t WS_SGA = WS_VA + al((size_t)MP * AW * 2);
constexpr size_t WS_SGB = WS_SGA + al((size_t)MP * DM * 2);
constexpr size_t WS_ST = WS_SGB + al((size_t)MP * DM * 2);
constexpr size_t WS_OG = WS_ST + al((size_t)16 * 31 * 512 * 256 * 2);
constexpr size_t WS_LSE = WS_OG + al((size_t)MP * AW * 2);
constexpr size_t WS_APA = WS_LSE + al((size_t)MP * 12 * 4);
constexpr size_t WS_OA = WS_APA + al((size_t)MP * RV * 2);
constexpr size_t WS_RSS1 = WS_OA + al((size_t)MP * AOUT * 2);
constexpr size_t WS_RSS2 = WS_RSS1 + al((size_t)MP * 16 * 4);
constexpr size_t WS_OS = WS_RSS2 + al((size_t)MP * 16 * 4);
constexpr size_t WS_END = WS_OS + MiB;
constexpr size_t WS_MERGED = WS_XN, WS_P = WS_QR, WS_H = WS_VR, WS_HB = WS_SGA, WS_HID = WS_ST;
static_assert((size_t)MP * FH * 2 <= (size_t)16 * 31 * 512 * 256 * 2, "HID overlays ST");
static_assert(WS_KR + (size_t)MP * DM * 2 - WS_QR >= (size_t)MP * DM * 4, "P overlays QR|KR");
static_assert(WS_END <= (size_t)1024 * MiB, "workspace map");
constexpr int CW_Q2 = 64, CW_Q3 = 128, CW_Q2B = 192, CW_Q3B = 256, CW_BAR = 4096;

constexpr int LDS_BYTES = 147456, LDS_MISC = 143360;

typedef __bf16 bf16x2_t __attribute__((ext_vector_type(2)));
__device__ __forceinline__ unsigned cvt_pk_bf16(float lo, float hi) { const f32x2 v = {lo, hi}; const bf16x2_t b = __builtin_convertvector(v, bf16x2_t); return __builtin_bit_cast(unsigned, b); }
__device__ __forceinline__ float bf2f(unsigned short b) { return __uint_as_float((unsigned)b << 16); }
__device__ __forceinline__ float bflo(unsigned w) { return __uint_as_float(w << 16); }
__device__ __forceinline__ float bfhi(unsigned w) { return __uint_as_float(w & 0xffff0000u); }
__device__ __forceinline__ float fexp2(float x) { return __builtin_amdgcn_exp2f(x); }
__device__ __forceinline__ float flog2(float x) { return __builtin_amdgcn_logf(x); }
__device__ __forceinline__ float frcp(float x) { return __builtin_amdgcn_rcpf(x); }
__device__ __forceinline__ float sigmoidf_(float x) { return frcp(1.0f + fexp2(-1.4426950408889634f * x)); }
__device__ __forceinline__ float siluf_(float x) { return x * sigmoidf_(x); }
__device__ __forceinline__ int opaque(int x) { asm volatile("" : "+v"(x)); return x; }
__device__ __forceinline__ float wave_sum(float v) {
#pragma unroll
    for (int o = 1; o < 64; o <<= 1) v += __shfl_xor(v, o);
    return v;
}
__device__ __forceinline__ s16x4 tr16(const LAS unsigned char* p) {
    typedef short v4i16_t __attribute__((ext_vector_type(4)));
    return __builtin_bit_cast(s16x4, __builtin_amdgcn_ds_read_tr16_b64_v4i16((LAS v4i16_t*)p));
}
__device__ __forceinline__ bf16x8 cat8(s16x4 a, s16x4 b) { bf16x8 r; r[0] = a[0]; r[1] = a[1]; r[2] = a[2]; r[3] = a[3]; r[4] = b[0]; r[5] = b[1]; r[6] = b[2]; r[7] = b[3]; return r; }
__device__ __forceinline__ f32x4 mfma16(bf16x8 a, bf16x8 b, f32x4 c) { return __builtin_amdgcn_mfma_f32_16x16x32_bf16(a, b, c, 0, 0, 0); }

namespace pg8 {
constexpr int BM = 256, BK = 64, HALF = 128, HTB = HALF * BK * 2, STAGE_BYTES = 8 * HTB, NXCD = 8, WGM = 8;
__host__ __device__ __forceinline__ int lds_byte(int r, int c) { const int st = (r >> 4) * 2 + (c >> 5), rr = r & 15, cc = c & 31, ob = rr * 64 + cc * 2; return st * 1024 + (ob ^ (((ob >> 9) & 1) << 5)); }
__host__ __device__ __forceinline__ void stage_rc(int b, int& R, int& C) { const int st = b / 1024, sb = b % 1024, swz = sb ^ (((sb >> 9) & 1) << 5); R = (st >> 1) * 16 + swz / 64; C = (st & 1) * 32 + (swz % 64) / 2; }
__host__ __device__ __forceinline__ int perm32(int rho) { const int n = rho >> 4, i = rho & 15; return 8 * (i >> 2) + 4 * n + (i & 3); }
struct Unit { int pm, pn; };
struct Gemm { const bf16_t* A; const bf16_t* Bt; int M, N, K; };
struct StaticOrder {
    int nM, nN, nwg, G, c;
    __host__ __device__ void init(int M, int N, int G_, int c_) { nM = M / BM; nN = N / BM; nwg = nM * nN; G = G_; c = c_; }
    __host__ __device__ bool next(int i, Unit& u) const {
        const long L = (long)i * G + c; if (L >= nwg) return false;
        int wgid = (int)L; { const int q = nwg / NXCD, r = nwg % NXCD, xcd = wgid % NXCD, off = wgid / NXCD; wgid = (xcd < r ? xcd * (q + 1) : r * (q + 1) + (xcd - r) * q) + off; }
        const int nig = WGM * nN, gid = wgid / nig, fm = gid * WGM, gsz = (nM - fm) < WGM ? (nM - fm) : WGM;
        u.pm = fm + ((wgid % nig) % gsz); u.pn = (wgid % nig) / gsz; return true;
    }
    __device__ __forceinline__ void a_ready(const Unit&) const {}
    __device__ __forceinline__ void done(const Unit&) const {}
};
template <class Epi, class Sched, bool ALIGN_EPI = false, bool SP2 = false>
__device__ __forceinline__ void gemm_phase(LAS unsigned char* lds, const Gemm g, const Sched& S, const Epi& E) {
    int tid_ = threadIdx.x; asm volatile("" : "+v"(tid_));
    const int tid = tid_, wid = __builtin_amdgcn_readfirstlane(tid >> 6), lane = tid & 63, wr = wid >> 2, wc = wid & 3, fr = lane & 15, fq = lane >> 4;
    const int K = g.K, nt = K / BK;
    unsigned voffA[2], voffB[2];
#pragma unroll
    for (int i = 0; i < 2; ++i) { int R, C; stage_rc(tid * 16 + i * 8192, R, C); const int Rb = Epi::PERM ? ((R & ~31) + perm32(R & 31)) : R;
        voffA[i] = (unsigned)(R * K + C) * 2u; voffB[i] = (unsigned)(Rb * K + C) * 2u; }
    const size_t kstep = (size_t)(BK * 2);
    const size_t hstep = (size_t)HALF * K * 2;
    const size_t tstep = 2 * hstep;
    const unsigned ldsw = (unsigned)wid * 1024u;
    const int aoff = lds_byte(wr * 64 + fr, fq * 8), boff = lds_byte(wc * 32 + fr, fq * 8);
#define PG8_SA(b, h) (((b) * 2 + (h)) * HTB)
#define PG8_SB(b, h) ((4 + (b) * 2 + (h)) * HTB)
#define PG8_STAGE(bufoff, gbase, voff) do { _Pragma("unroll") for (int _i = 0; _i < 2; ++_i) \
        __builtin_amdgcn_global_load_lds((const unsigned*)((const char*)(gbase) + (voff)[_i]), (LAS unsigned*)(lds + (bufoff) + ldsw + _i * 8192), 16, 0, 0); } while (0)
#define PG8_LDA(dst, b, h) do { _Pragma("unroll") for (int m = 0; m < 4; ++m) _Pragma("unroll") for (int k = 0; k < 2; ++k) dst[m][k] = *(const LAS bf16x8*)(lds + PG8_SA(b, h) + aoff + m * 2048 + k * 1024); } while (0)
#define PG8_LDB(dst, b, h) do { _Pragma("unroll") for (int n = 0; n < 2; ++n) _Pragma("unroll") for (int k = 0; k < 2; ++k) dst[n][k] = *(const LAS bf16x8*)(lds + PG8_SB(b, h) + boff + n * 2048 + k * 1024); } while (0)
#define PG8_MMA(ai, bj, At, Bt) do { __builtin_amdgcn_s_setprio(1); _Pragma("unroll") for (int m = 0; m < 4; ++m) _Pragma("unroll") for (int n = 0; n < 2; ++n) _Pragma("unroll") for (int k = 0; k < 2; ++k) \
        acc[ai][bj][m][n] = __builtin_amdgcn_mfma_f32_16x16x32_bf16(Bt[n][k], At[m][k], acc[ai][bj][m][n], 0, 0, 0); __builtin_amdgcn_s_setprio(0); } while (0)
#define PG8_WAIT_V(n) asm volatile("s_waitcnt vmcnt(" #n ")" ::: "memory")
#define PG8_WAIT_L(n) asm volatile("s_waitcnt lgkmcnt(" #n ")" ::: "memory")
#define PG8_BAR __builtin_amdgcn_s_barrier()
#define PG8_SCHED __builtin_amdgcn_sched_barrier(0)
    Unit cur, nxt; int ui = 0;
    if (!S.next(0, cur)) return;
    f32x4 acc[2][2][4][2];
#pragma unroll
    for (int a = 0; a < 2; ++a)
#pragma unroll
        for (int b = 0; b < 2; ++b)
#pragma unroll
            for (int m = 0; m < 4; ++m)
#pragma unroll
                for (int n = 0; n < 2; ++n) acc[a][b][m][n] = (f32x4){0.f, 0.f, 0.f, 0.f};
    bf16x8 At[4][2], B0[2][2], B1[2][2];
    const char* cA = (const char*)g.A + (size_t)cur.pm * tstep; const char* cB = (const char*)g.Bt + (size_t)cur.pn * tstep;
    S.a_ready(cur);
    if constexpr (SP2) {
        PG8_STAGE(PG8_SB(0, 0), cB, voffB); PG8_STAGE(PG8_SB(0, 1), cB + hstep, voffB); PG8_STAGE(PG8_SA(0, 0), cA, voffA); PG8_STAGE(PG8_SA(0, 1), cA + hstep, voffA);
        if (wr == 1) PG8_BAR;
        PG8_WAIT_V(2); PG8_BAR;
        PG8_STAGE(PG8_SB(1, 0), cB + kstep, voffB); PG8_STAGE(PG8_SA(1, 0), cA + kstep, voffA); PG8_STAGE(PG8_SB(1, 1), cB + hstep + kstep, voffB);
        PG8_WAIT_V(6); PG8_BAR;
    } else {
        PG8_STAGE(PG8_SB(0, 0), cB, voffB); PG8_STAGE(PG8_SA(0, 0), cA, voffA); PG8_STAGE(PG8_SB(0, 1), cB + hstep, voffB); PG8_STAGE(PG8_SA(0, 1), cA + hstep, voffA);
        if (wr == 1) PG8_BAR;
        PG8_WAIT_V(4); PG8_BAR;
        PG8_STAGE(PG8_SB(1, 0), cB + kstep, voffB); PG8_STAGE(PG8_SA(1, 0), cA + kstep, voffA); PG8_STAGE(PG8_SB(1, 1), cB + hstep + kstep, voffB);
        PG8_WAIT_V(6); PG8_BAR;
    }
    for (;;) {
        const bool has_next = S.next(ui + 1, nxt);
        const char* nA = has_next ? (const char*)g.A + (size_t)nxt.pm * tstep : cA; const char* nB = has_next ? (const char*)g.Bt + (size_t)nxt.pn * tstep : cB;
        for (int t = 0; t < nt; t += 2) {
            const bool last = (t == nt - 2);
            const char* a1 = cA + (size_t)(t + 1) * kstep;
            const char* a2 = last ? nA : cA + (size_t)(t + 2) * kstep; const char* b2 = last ? nB : cB + (size_t)(t + 2) * kstep;
            const char* a3 = a2 + kstep; const char* b3 = b2 + kstep;
            if (last && has_next) S.a_ready(nxt);
            if constexpr (SP2) {
            PG8_LDB(B0, 0, 0); PG8_LDB(B1, 0, 1); PG8_SCHED; PG8_LDA(At, 0, 0); PG8_STAGE(PG8_SA(1, 1), a1 + hstep, voffA);
            PG8_WAIT_V(8); PG8_WAIT_L(0); PG8_BAR; PG8_MMA(0, 0, At, B0); PG8_MMA(0, 1, At, B1); PG8_BAR; PG8_SCHED;
            PG8_LDA(At, 0, 1); PG8_STAGE(PG8_SB(0, 0), b2, voffB); PG8_STAGE(PG8_SB(0, 1), b2 + hstep, voffB); PG8_STAGE(PG8_SA(0, 0), a2, voffA);
            PG8_WAIT_V(8); PG8_WAIT_L(0); PG8_BAR; PG8_MMA(1, 0, At, B0); PG8_MMA(1, 1, At, B1); PG8_BAR; PG8_SCHED;
            PG8_LDB(B0, 1, 0); PG8_LDB(B1, 1, 1); PG8_SCHED; PG8_LDA(At, 1, 0); PG8_STAGE(PG8_SA(0, 1), a2 + hstep, voffA);
            PG8_WAIT_V(8); PG8_WAIT_L(0); PG8_BAR; PG8_MMA(0, 0, At, B0); PG8_MMA(0, 1, At, B1); PG8_BAR; PG8_SCHED;
            PG8_LDA(At, 1, 1); PG8_STAGE(PG8_SB(1, 0), b3, voffB); PG8_STAGE(PG8_SB(1, 1), b3 + hstep, voffB); PG8_STAGE(PG8_SA(1, 0), a3, voffA);
            PG8_WAIT_V(8); PG8_WAIT_L(0); PG8_BAR; PG8_MMA(1, 0, At, B0); PG8_MMA(1, 1, At, B1); PG8_BAR; PG8_SCHED;
            } else {
            PG8_LDB(B0, 0, 0); PG8_SCHED; PG8_LDA(At, 0, 0); PG8_STAGE(PG8_SA(1, 1), a1 + hstep, voffA);
            PG8_WAIT_L(8); PG8_BAR; PG8_WAIT_L(0); PG8_MMA(0, 0, At, B0); PG8_BAR; PG8_SCHED;
            PG8_LDB(B1, 0, 1); PG8_STAGE(PG8_SB(0, 0), b2, voffB);
            PG8_BAR; PG8_WAIT_L(0); PG8_MMA(0, 1, At, B1); PG8_BAR;
            PG8_LDA(At, 0, 1); PG8_STAGE(PG8_SA(0, 0), a2, voffA);
            PG8_BAR; PG8_WAIT_L(0); PG8_MMA(1, 0, At, B0); PG8_BAR; PG8_SCHED;
            PG8_STAGE(PG8_SB(0, 1), b2 + hstep, voffB);
            PG8_WAIT_V(6); PG8_BAR; PG8_MMA(1, 1, At, B1); PG8_BAR;
            PG8_LDB(B0, 1, 0); PG8_SCHED; PG8_LDA(At, 1, 0); PG8_STAGE(PG8_SA(0, 1), a2 + hstep, voffA);
            PG8_WAIT_L(8); PG8_BAR; PG8_WAIT_L(0); PG8_MMA(0, 0, At, B0); PG8_BAR; PG8_SCHED;
            PG8_LDB(B1, 1, 1); PG8_STAGE(PG8_SB(1, 0), b3, voffB);
            PG8_BAR; PG8_WAIT_L(0); PG8_MMA(0, 1, At, B1); PG8_BAR;
            PG8_LDA(At, 1, 1); PG8_STAGE(PG8_SA(1, 0), a3, voffA);
            PG8_BAR; PG8_WAIT_L(0); PG8_MMA(1, 0, At, B0); PG8_BAR; PG8_SCHED;
            PG8_STAGE(PG8_SB(1, 1), b3 + hstep, voffB);
            PG8_WAIT_V(6); PG8_BAR; PG8_MMA(1, 1, At, B1); PG8_BAR;
            }
        }
        if constexpr (ALIGN_EPI) { if (wr == 0) PG8_BAR; }
        if constexpr (!Epi::AFTER_DRAIN) { E(acc, cur, wr, wc, fr, fq); S.done(cur); }
        if (!has_next) break;
#pragma unroll
        for (int a = 0; a < 2; ++a)
#pragma unroll
            for (int b = 0; b < 2; ++b)
#pragma unroll
                for (int m = 0; m < 4; ++m)
#pragma unroll
                    for (int n = 0; n < 2; ++n) acc[a][b][m][n] = (f32x4){0.f, 0.f, 0.f, 0.f};
        cur = nxt; cA = nA; cB = nB; ++ui;
        if constexpr (ALIGN_EPI) { if (wr == 1) PG8_BAR; }
    }
    PG8_WAIT_V(0);
    if constexpr (!ALIGN_EPI) { if (wr == 0) PG8_BAR; }
    PG8_BAR;
#undef PG8_SA
#undef PG8_SB
#undef PG8_STAGE
#undef PG8_LDA
#undef PG8_LDB
#undef PG8_MMA
#undef PG8_WAIT_V
#undef PG8_WAIT_L
#undef PG8_BAR
#undef PG8_SCHED
}
}
using pg8::Unit;

__device__ __forceinline__ u32x4 pack8(f32x4 a, f32x4 b) { u32x4 w; w.x = cvt_pk_bf16(a[0], a[1]); w.y = cvt_pk_bf16(a[2], a[3]); w.z = cvt_pk_bf16(b[0], b[1]); w.w = cvt_pk_bf16(b[2], b[3]); return w; }
__device__ __forceinline__ void unpack8(u32x4 w, f32x4& a, f32x4& b) { a[0] = bflo(w.x); a[1] = bfhi(w.x); a[2] = bflo(w.y); a[3] = bfhi(w.y); b[0] = bflo(w.z); b[1] = bfhi(w.z); b[2] = bflo(w.w); b[3] = bfhi(w.w); }

struct EpiIn {
    static constexpr bool PERM = true, AFTER_DRAIN = false;
    unsigned char* ws; const float *ropec, *ropes; float* out;
    __device__ __forceinline__ void operator()(const f32x4 (&acc)[2][2][4][2], const Unit& u, int wr, int wc, int fr, int fq) const {
        const int pn = u.pn, rbase = u.pm * 256 + wr * 64 + fr, cb = wc * 32 + 8 * fq;
        if (pn < 8) {
            const int h = pn & 3; const bool isq = pn < 4; bf16_t* dst = (bf16_t*)(ws + (isq ? WS_QR : WS_KR)); const float lg = lg2_gamma(h);
#pragma unroll
            for (int ai = 0; ai < 2; ++ai)
#pragma unroll
                for (int m = 0; m < 4; ++m) {
                    const int row = rbase + ai * 128 + m * 16; const int pidx = row < TP ? (row & (SEQ - 1)) : 4096;
                    float sc;
                    if (row < TP) { const int tt = row & 127; sc = isq ? fexp2((float)(tt + 1) * lg) : 0.0625f * fexp2((float)(127 - tt) * lg); } else sc = isq ? 1.0f : 0.0625f;
                    f32x4 o1[2], o2[2];
#pragma unroll
                    for (int n = 0; n < 2; ++n) {
                        const f32x4 c = *(const f32x4*)(ropec + (size_t)pidx * 128 + cb + 4 * n), s = *(const f32x4*)(ropes + (size_t)pidx * 128 + cb + 4 * n);
                        const f32x4 x1 = acc[ai][0][m][n], x2 = acc[ai][1][m][n];
                        o1[n] = (x1 * c - x2 * s) * sc; o2[n] = (x1 * s + x2 * c) * sc;
                    }
                    bf16_t* p = dst + (size_t)row * DM + h * 256 + cb;
                    *(u32x4*)p = pack8(o1[0], o1[1]); *(u32x4*)(p + 128) = pack8(o2[0], o2[1]);
                }
            return;
        }
        size_t doff; int ld, col0; int mode = 0; float scl = 1.0f;
        if (pn < 16) { doff = WS_VR; ld = RV; col0 = (pn - 8) * 256; }
        else if (pn < 24) { doff = WS_GS; ld = RV; col0 = (pn - 16) * 256; mode = 1; }
        else if (pn < 30) { doff = WS_QA; ld = AW; col0 = (pn - 24) * 256; scl = QSCALE_A; }
        else if (pn < 36) { doff = WS_KA; ld = AW; col0 = (pn - 30) * 256; }
        else if (pn < 42) { doff = WS_VA; ld = AW; col0 = (pn - 36) * 256; }
        else if (pn < 46) { doff = WS_SGA; ld = DM; col0 = (pn - 42) * 256; mode = 2; }
        else { doff = WS_SGB; ld = DM; col0 = (pn - 46) * 256; mode = 2; }
        bf16_t* dst = (bf16_t*)(ws + doff);
        const bool iskv = pn >= 30 && pn < 42;
        int kvsel = 0, grp = 0, half = 0, win = 0; size_t obp = 0, obs = 0;
        if (iskv) { const int idx = pn >= 36 ? pn - 36 : pn - 30; kvsel = pn >= 36 ? 1 : 0; grp = idx >> 1; half = idx & 1; win = 128 << (2 * grp);
            obp = grp == 0 ? O_KV0P : grp == 1 ? O_KV1P : O_KV2P; obs = grp == 0 ? O_KV0S : grp == 1 ? O_KV1S : O_KV2S; }
#pragma unroll
        for (int ai = 0; ai < 2; ++ai)
#pragma unroll
            for (int m = 0; m < 4; ++m) {
                const int row = rbase + ai * 128 + m * 16;
#pragma unroll
                for (int bj = 0; bj < 2; ++bj) {
                    f32x4 v0 = acc[ai][bj][m][0], v1 = acc[ai][bj][m][1];
                    if (iskv) {
                        float* op = nullptr;
                        if (row < TP) { const int t = row & (SEQ - 1), b = row >> 12; if (t >= SEQ - win) op = out + obp + ((size_t)(b * win + (t - (SEQ - win))) * 2 + kvsel) * 512 + half * 256 + bj * 128 + cb; }
                        else if (row < MR) op = out + obs + ((size_t)(row - TP) * 2 + kvsel) * 512 + half * 256 + bj * 128 + cb;
                        if (op) { *(f32x4*)op = v0; *(f32x4*)(op + 4) = v1; }
                    }
                    if (mode == 1) {
#pragma unroll
                        for (int i = 0; i < 4; ++i) { v0[i] = siluf_(v0[i]); v1[i] = siluf_(v1[i]); }
                    } else if (mode == 2) {
#pragma unroll
                        for (int i = 0; i < 4; ++i) { v0[i] = sigmoidf_(v0[i]); v1[i] = sigmoidf_(v1[i]); }
                    } else { v0 = v0 * scl; v1 = v1 * scl; }
                    *(u32x4*)(dst + (size_t)row * ld + col0 + bj * 128 + cb) = pack8(v0, v1);
                }
            }
    }
};

struct EpiPa {
    static constexpr bool PERM = true, AFTER_DRAIN = false;
    const bf16_t* SGA; float* P;
    __device__ __forceinline__ void operator()(const f32x4 (&acc)[2][2][4][2], const Unit& u, int wr, int wc, int fr, int fq) const {
        const int rbase = u.pm * 256 + wr * 64 + fr, cb = u.pn * 256 + wc * 32 + 8 * fq;
#pragma unroll
        for (int ai = 0; ai < 2; ++ai)
#pragma unroll
            for (int m = 0; m < 4; ++m) { const size_t ro = (size_t)(rbase + ai * 128 + m * 16) * DM + cb;
#pragma unroll
                for (int bj = 0; bj < 2; ++bj) { f32x4 g0, g1; unpack8(*(const u32x4*)(SGA + ro + bj * 128), g0, g1);
                    *(f32x4*)(P + ro + bj * 128) = acc[ai][bj][m][0] * g0; *(f32x4*)(P + ro + bj * 128 + 4) = acc[ai][bj][m][1] * g1; } }
    }
};
struct EpiPb {
    static constexpr bool PERM = true, AFTER_DRAIN = false;
    const bf16_t* SGB; const float* P; bf16_t* MG;
    __device__ __forceinline__ void operator()(const f32x4 (&acc)[2][2][4][2], const Unit& u, int wr, int wc, int fr, int fq) const {
        const int rbase = u.pm * 256 + wr * 64 + fr, cb = u.pn * 256 + wc * 32 + 8 * fq;
#pragma unroll
        for (int ai = 0; ai < 2; ++ai)
#pragma unroll
            for (int m = 0; m < 4; ++m) { const size_t ro = (size_t)(rbase + ai * 128 + m * 16) * DM + cb;
#pragma unroll
                for (int bj = 0; bj < 2; ++bj) { f32x4 g0, g1; unpack8(*(const u32x4*)(SGB + ro + bj * 128), g0, g1);
                    const f32x4 p0 = *(const f32x4*)(P + ro + bj * 128), p1 = *(const f32x4*)(P + ro + bj * 128 + 4);
                    *(u32x4*)(MG + ro + bj * 128) = pack8(p0 + acc[ai][bj][m][0] * g0, p1 + acc[ai][bj][m][1] * g1); } }
    }
};
struct EpiO {
    static constexpr bool PERM = true, AFTER_DRAIN = false;
    const float *xp, *xs; float* H; bf16_t* HB; float* RSS;
    __device__ __forceinline__ void operator()(const f32x4 (&acc)[2][2][4][2], const Unit& u, int wr, int wc, int fr, int fq) const {
        const int rbase = u.pm * 256 + wr * 64 + fr, cb = u.pn * 256 + wc * 32 + 8 * fq;
#pragma unroll
        for (int ai = 0; ai < 2; ++ai)
#pragma unroll
            for (int m = 0; m < 4; ++m) { const int row = rbase + ai * 128 + m * 16; const size_t ro = (size_t)row * DM + cb;
                const float* xr = row < TP ? xp + ro : (row < MR ? xs + (size_t)(row - TP) * DM + cb : nullptr);
                float ss = 0.f;
#pragma unroll
                for (int bj = 0; bj < 2; ++bj) {
                    f32x4 x0 = (f32x4){0.f, 0.f, 0.f, 0.f}, x1 = x0; if (xr) { x0 = *(const f32x4*)(xr + bj * 128); x1 = *(const f32x4*)(xr + bj * 128 + 4); }
                    const f32x4 h0 = x0 + acc[ai][bj][m][0], h1 = x1 + acc[ai][bj][m][1];
                    *(f32x4*)(H + ro + bj * 128) = h0; *(f32x4*)(H + ro + bj * 128 + 4) = h1; *(u32x4*)(HB + ro + bj * 128) = pack8(h0, h1);
                    ss += (h0[0] * h0[0] + h0[1] * h0[1]) + (h0[2] * h0[2] + h0[3] * h0[3]) + (h1[0] * h1[0] + h1[1] * h1[1]) + (h1[2] * h1[2] + h1[3] * h1[3]);
                }
                ss += __shfl_xor(ss, 16); ss += __shfl_xor(ss, 32);
                if (fq == 0) RSS[(size_t)row * 16 + u.pn * 4 + wc] = ss;
            }
    }
};
struct EpiFi {
    static constexpr bool PERM = true, AFTER_DRAIN = false;
    const float* RSS; bf16_t* HID;
    __device__ __forceinline__ void operator()(const f32x4 (&acc)[2][2][4][2], const Unit& u, int wr, int wc, int fr, int fq) const {
        const int rbase = u.pm * 256 + wr * 64 + fr, cb = u.pn * 128 + wc * 32 + 8 * fq;
#pragma unroll
        for (int ai = 0; ai < 2; ++ai)
#pragma unroll
            for (int m = 0; m < 4; ++m) { const int row = rbase + ai * 128 + m * 16;
                const f32x4* rp = (const f32x4*)(RSS + (size_t)row * 16); const f32x4 r0 = rp[0], r1 = rp[1], r2 = rp[2], r3 = rp[3];
                const float ssum = ((r0[0] + r0[1]) + (r0[2] + r0[3])) + ((r1[0] + r1[1]) + (r1[2] + r1[3])) + ((r2[0] + r2[1]) + (r2[2] + r2[3])) + ((r3[0] + r3[1]) + (r3[2] + r3[3]));
                const float rinv = rsqrtf(ssum * (1.0f / DM) + EPS);
                f32x4 o[2];
#pragma unroll
                for (int n = 0; n < 2; ++n) { const f32x4 a = acc[ai][0][m][n] * rinv, b = acc[ai][1][m][n] * rinv;
#pragma unroll
                    for (int i = 0; i < 4; ++i) o[n][i] = siluf_(a[i]) * b[i]; }
                *(u32x4*)(HID + (size_t)row * FH + cb) = pack8(o[0], o[1]);
            }
    }
};
struct EpiFo {
    static constexpr bool PERM = true, AFTER_DRAIN = false;
    const float* H; float* Y; float* RSS;
    __device__ __forceinline__ void operator()(const f32x4 (&acc)[2][2][4][2], const Unit& u, int wr, int wc, int fr, int fq) const {
        const int rbase = u.pm * 256 + wr * 64 + fr, cb = u.pn * 256 + wc * 32 + 8 * fq;
#pragma unroll
        for (int ai = 0; ai < 2; ++ai)
#pragma unroll
            for (int m = 0; m < 4; ++m) { const int row = rbase + ai * 128 + m * 16; const size_t ro = (size_t)row * DM + cb;
                float ss = 0.f;
#pragma unroll
                for (int bj = 0; bj < 2; ++bj) {
                    const f32x4 h0 = *(const f32x4*)(H + ro + bj * 128) + acc[ai][bj][m][0], h1 = *(const f32x4*)(H + ro + bj * 128 + 4) + acc[ai][bj][m][1];
                    if (row < MR) { *(f32x4*)(Y + ro + bj * 128) = h0; *(f32x4*)(Y + ro + bj * 128 + 4) = h1; }
                    ss += (h0[0] * h0[0] + h0[1] * h0[1]) + (h0[2] * h0[2] + h0[3] * h0[3]) + (h1[0] * h1[0] + h1[1] * h1[1]) + (h1[2] * h1[2] + h1[3] * h1[3]);
                }
                ss += __shfl_xor(ss, 16); ss += __shfl_xor(ss, 32);
                if (fq == 0) RSS[(size_t)row * 16 + u.pn * 4 + wc] = ss;
            }
    }
};

struct Args {
    const float* in[16]; float* out; unsigned char* ws;
};
struct Ctx {
    LAS unsigned char* lds; int tid, lane, wave, G, bid;
    const __attribute__((address_space(4))) Args* ka;
    float* out; unsigned char* ws;
};
#define WSP(T, off) ((T*)(C.ws + (off)))

template <int MODE>
__device__ __forceinline__ void p0_transpose_item(const float* W, int K, int N, bf16_t* WT, const float* kscale, LAS float* scr, int item, int lane) {
    const int nblk = N / 32, kb = item / nblk, nb = item % nblk, k0 = 64 * kb, n0 = 32 * nb;
#pragma unroll 8
    for (int i = 0; i < 32; ++i) { const int kk = 2 * i + (lane >> 5); float v = W[(size_t)(k0 + kk) * N + n0 + (lane & 31)]; if (kscale) v *= kscale[k0 + kk]; scr[kk * 33 + (lane & 31)] = v; }
    asm volatile("s_waitcnt lgkmcnt(0)" ::: "memory");
    const int c = lane & 7;
#pragma unroll
    for (int j = 0; j < 4; ++j) { const int n = (lane >> 3) + 8 * j; const LAS float* s = scr + (8 * c) * 33 + n;
        u32x4 o; o.x = cvt_pk_bf16(s[0 * 33], s[1 * 33]); o.y = cvt_pk_bf16(s[2 * 33], s[3 * 33]); o.z = cvt_pk_bf16(s[4 * 33], s[5 * 33]); o.w = cvt_pk_bf16(s[6 * 33], s[7 * 33]);
        int nn = n0 + n;
        if (MODE == 1) { nn = nn < FH ? (nn >> 7) * 256 + (nn & 127) : ((nn - FH) >> 7) * 256 + 128 + ((nn - FH) & 127); }
        *(u32x4*)(WT + (size_t)nn * K + k0 + 8 * c) = o; }
    asm volatile("s_waitcnt lgkmcnt(0)" ::: "memory");
}
__device__ __forceinline__ void p0_prep(const Ctx& C) {
    LAS float* scr = (LAS float*)(C.lds + C.wave * 16384);
    const int gw = C.bid * 8 + C.wave, NGW = C.G * 8, lane = C.lane;
    constexpr int I_IN = (DM / 64) * (NIN / 32), I_PA = (RV / 64) * (DM / 32), I_PB = (AOUT / 64) * (DM / 32), I_O = (DM / 64) * (DM / 32), I_FI = (DM / 64) * (2 * FH / 32), I_FO = (FH / 64) * (DM / 32);
    constexpr int NITEMS = I_IN + I_PA + I_PB + I_O + I_FI + I_FO;
    for (int it = gw; it < NITEMS; it += NGW) {
        int r = it;
        if (r < I_IN) { p0_transpose_item<0>(C.ka->in[7], DM, NIN, WSP(bf16_t, WS_WIN), nullptr, scr, r, lane); continue; } r -= I_IN;
        if (r < I_PA) { p0_transpose_item<0>(C.ka->in[9], RV, DM, WSP(bf16_t, WS_WPA), nullptr, scr, r, lane); continue; } r -= I_PA;
        if (r < I_PB) { p0_transpose_item<0>(C.ka->in[10], AOUT, DM, WSP(bf16_t, WS_WPB), nullptr, scr, r, lane); continue; } r -= I_PB;
        if (r < I_O) { p0_transpose_item<0>(C.ka->in[11], DM, DM, WSP(bf16_t, WS_WO), nullptr, scr, r, lane); continue; } r -= I_O;
        if (r < I_FI) { p0_transpose_item<1>(C.ka->in[13], DM, 2 * FH, WSP(bf16_t, WS_WFI), C.ka->in[12], scr, r, lane); continue; } r -= I_FI;
        p0_transpose_item<0>(C.ka->in[14], FH, DM, WSP(bf16_t, WS_WFO), nullptr, scr, r, lane);
    }
    const f32x4* g4 = (const f32x4*)C.ka->in[6];
    bf16_t* XN = WSP(bf16_t, WS_XN);
    for (int row = gw; row < MP; row += NGW) {
        u32x2* o8 = (u32x2*)(XN + (size_t)row * DM) + lane;
        if (row >= MR) {
#pragma unroll
            for (int j = 0; j < 4; ++j) o8[64 * j] = (u32x2){0u, 0u};
            continue; }
        const f32x4* xr = (const f32x4*)(row < TP ? C.ka->in[0] + (size_t)row * DM : C.ka->in[1] + (size_t)(row - TP) * DM) + lane;
        f32x4 v[4]; float s = 0.f;
#pragma unroll
        for (int j = 0; j < 4; ++j) { v[j] = xr[64 * j]; s += (v[j][0] * v[j][0] + v[j][1] * v[j][1]) + (v[j][2] * v[j][2] + v[j][3] * v[j][3]); }
        const float rinv = rsqrtf(wave_sum(s) * (1.0f / DM) + EPS);
#pragma unroll
        for (int j = 0; j < 4; ++j) { const f32x4 g = g4[lane + 64 * j]; const f32x4 y = v[j] * rinv * g; o8[64 * j] = (u32x2){cvt_pk_bf16(y[0], y[1]), cvt_pk_bf16(y[2], y[3])}; }
    }
    float* rc = WSP(float, WS_ROPEC); float* rs = WSP(float, WS_ROPES);
    for (int e = (C.bid * 512 + C.tid); e < 4097 * 128; e += C.G * 512) {
        const int p = e >> 7, j = e & 127; const float pos = p < 4096 ? (float)p : (float)PAST;
        const float inv = exp2f(-(float)j * (13.287712379549449f / 128.0f));
        const float ang = pos * inv;
        double r = (double)ang * 0.15915494309189535; r -= floor(r);
        const float fr = (float)r;
        rc[e] = __builtin_amdgcn_cosf(fr); rs[e] = __builtin_amdgcn_sinf(fr);
    }
    { u32x4* pa = (u32x4*)(WSP(bf16_t, WS_APA) + (size_t)MR * RV); const int n1 = (MP - MR) * RV / 8;
      for (int e = C.bid * 512 + C.tid; e < n1; e += C.G * 512) pa[e] = (u32x4){0u, 0u, 0u, 0u};
      u32x4* oa = (u32x4*)(WSP(bf16_t, WS_OA) + (size_t)MR * AOUT); const int n2 = (MP - MR) * AOUT / 8;
      for (int e = C.bid * 512 + C.tid; e < n2; e += C.G * 512) oa[e] = (u32x4){0u, 0u, 0u, 0u}; }
}

__device__ __forceinline__ int wq_first(const Ctx& C, unsigned* ctr) {
    volatile LAS int* slot = (volatile LAS int*)(C.lds + LDS_MISC);
    __syncthreads();
    if (C.tid == 0) *slot = (int)__hip_atomic_fetch_add(ctr, 1u, __ATOMIC_RELAXED, __HIP_MEMORY_SCOPE_AGENT);
    __syncthreads();
    return *slot;
}
__device__ __forceinline__ unsigned wq_prefetch(const Ctx& C, unsigned* ctr) { return C.tid == 0 ? __hip_atomic_fetch_add(ctr, 1u, __ATOMIC_RELAXED, __HIP_MEMORY_SCOPE_AGENT) : 0u; }
__device__ __forceinline__ int wq_take(const Ctx& C, unsigned nxt) {
    volatile LAS int* slot = (volatile LAS int*)(C.lds + LDS_MISC);
    __syncthreads();
    if (C.tid == 0) *slot = (int)nxt;
    __syncthreads();
    return *slot;
}

__device__ __forceinline__ void ret_chain_task(const Ctx& C, int task) {
    const int bh = task >> 3, sl = task & 7, b = bh >> 2, h = bh & 3, lane = opaque(C.lane), tid = opaque(C.tid), w = C.wave, g = lane >> 4, q4 = (lane & 15) >> 2, p4 = lane & 3;
    const bf16_t* KR = WSP(const bf16_t, WS_KR) + (size_t)b * SEQ * DM + h * 256; const bf16_t* VR = WSP(const bf16_t, WS_VR) + (size_t)b * SEQ * RV + h * 512 + sl * 64;
    bf16_t* ST = WSP(bf16_t, WS_ST);
    constexpr int SLOT = 64 * 528 + 64 * 144;
    const float cdec = fexp2(128.0f * lg2_gamma(h));
    const int kr_r = tid >> 5, kr_c = tid & 31, vr_r = tid >> 3, vr_c = tid & 7;
    const bf16_t* kp = KR + (size_t)kr_r * DM + kr_c * 8; const bf16_t* vp = VR + (size_t)vr_r * RV + vr_c * 8;
    const int kl = kr_r * 528 + kr_c * 16, vl = 64 * 528 + vr_r * 144 + vr_c * 16;
    u32x4 rk[4][4], rv[4];
#define CH_LOAD(set_, s_) do { const size_t ro_ = (size_t)(s_) * 64; _Pragma("unroll") for (int i_ = 0; i_ < 4; ++i_) rk[set_][i_] = *(const u32x4*)(kp + (ro_ + 16 * i_) * DM); rv[set_] = *(const u32x4*)(vp + ro_ * RV); } while (0)
#define CH_STORE(set_, slot_) do { LAS unsigned char* d_ = C.lds + (slot_) * SLOT; _Pragma("unroll") for (int i_ = 0; i_ < 4; ++i_) *(LAS u32x4*)(d_ + kl + i_ * 16 * 528) = rk[set_][i_]; *(LAS u32x4*)(d_ + vl) = rv[set_]; } while (0)
    f32x4 acc[2][4];
#pragma unroll
    for (int i = 0; i < 2; ++i)
#pragma unroll
        for (int j = 0; j < 4; ++j) acc[i][j] = (f32x4){0.f, 0.f, 0.f, 0.f};
    __syncthreads();
    CH_LOAD(0, 0); CH_LOAD(1, 1); CH_LOAD(2, 2); CH_LOAD(3, 3);
    CH_STORE(0, 0); CH_LOAD(0, 4);
    __syncthreads();
#pragma unroll 1
    for (int s4 = 0; s4 < 64; s4 += 4) {
#pragma unroll
        for (int u = 0; u < 4; ++u) {
            const int s = s4 + u, cur = s % 3, nx1 = (s + 1) % 3;
            if (s + 1 < 64) { CH_STORE((u + 1) & 3, nx1); }
            if (s + 5 < 64) { CH_LOAD((u + 1) & 3, s + 5); }
            if (u == 0 || u == 2) { if (s > 0) {
#pragma unroll
                for (int i = 0; i < 2; ++i)
#pragma unroll
                    for (int j = 0; j < 4; ++j) acc[i][j] = acc[i][j] * cdec; } }
            const LAS unsigned char* KT = C.lds + cur * SLOT; const LAS unsigned char* VT = KT + 64 * 528;
#pragma unroll
            for (int ks = 0; ks < 2; ++ks) {
                bf16x8 A[2], B[4];
                const int rr = 32 * ks + 8 * g + q4;
#pragma unroll
                for (int md = 0; md < 2; ++md) A[md] = cat8(tr16(KT + rr * 528 + (32 * w + 16 * md) * 2 + 8 * p4), tr16(KT + (rr + 4) * 528 + (32 * w + 16 * md) * 2 + 8 * p4));
#pragma unroll
                for (int nv = 0; nv < 4; ++nv) B[nv] = cat8(tr16(VT + rr * 144 + (16 * nv) * 2 + 8 * p4), tr16(VT + (rr + 4) * 144 + (16 * nv) * 2 + 8 * p4));
#pragma unroll
                for (int md = 0; md < 2; ++md)
#pragma unroll
                    for (int nv = 0; nv < 4; ++nv) acc[md][nv] = mfma16(A[md], B[nv], acc[md][nv]);
            }
            if (u == 1 || u == 3) {
                const int c = s >> 1;
                if (c < 31) {
#pragma unroll
                    for (int md = 0; md < 2; ++md)
#pragma unroll
                        for (int nv = 0; nv < 4; ++nv) { const int v = sl * 64 + 16 * nv + (lane & 15), d = 32 * w + 16 * md + 4 * g;
                            *(u32x2*)(ST + (((size_t)(bh * 31 + c) * 512 + v) * 256 + d)) = (u32x2){cvt_pk_bf16(acc[md][nv][0], acc[md][nv][1]), cvt_pk_bf16(acc[md][nv][2], acc[md][nv][3])}; }
                } else {
                    float* SP = C.out + O_SP + (size_t)bh * 256 * 512;
#pragma unroll
                    for (int md = 0; md < 2; ++md)
#pragma unroll
                        for (int nv = 0; nv < 4; ++nv)
#pragma unroll
                            for (int r = 0; r < 4; ++r) SP[(size_t)(32 * w + 16 * md + 4 * g + r) * 512 + sl * 64 + 16 * nv + (lane & 15)] = acc[md][nv][r];
                }
            }
            __syncthreads();
        }
    }
#undef CH_LOAD
#undef CH_STORE
}

__device__ __forceinline__ void attn_unit(const Ctx& C, int uid) {
    const int b = uid / 384; int rem = uid % 384; const int grp = rem >> 7; rem &= 127; const int head = rem >> 5, sb = rem & 31;
    const int dil = 1 << (2 * grp), nblk = 32 >> (2 * grp), r = sb / nblk, nb = sb % nblk;
    const int col0 = grp * 512 + head * 128, lane = opaque(C.lane), w = C.wave, g = lane >> 4, q4 = (lane & 15) >> 2, p4 = lane & 3;
    const bf16_t* QA = WSP(const bf16_t, WS_QA); const bf16_t* KA = WSP(const bf16_t, WS_KA); const bf16_t* VA = WSP(const bf16_t, WS_VA);
    LAS unsigned char* KT = C.lds; LAS unsigned char* VT = C.lds + 256 * 272;
    __syncthreads();
    for (int i = C.tid; i < 256 * 16; i += 512) { const int jj = i >> 4, ch = i & 15; int n = 128 * (nb - 1) + jj; n = n < 0 ? 0 : n;
        const size_t row = (size_t)b * SEQ + (size_t)n * dil + r;
        *(LAS u32x4*)(KT + jj * 272 + ch * 16) = *(const u32x4*)(KA + row * AW + col0 + ch * 8);
        *(LAS u32x4*)(VT + jj * 272 + ch * 16) = *(const u32x4*)(VA + row * AW + col0 + ch * 8); }
    const int qi = 16 * w + (lane & 15); const size_t qrow = (size_t)b * SEQ + (size_t)(128 * nb + qi) * dil + r;
    bf16x8 qf[4];
#pragma unroll
    for (int ks = 0; ks < 4; ++ks) qf[ks] = *(const bf16x8*)(QA + qrow * AW + col0 + 32 * ks + 8 * g);
    __syncthreads();
    f32x4 s[16];
#pragma unroll
    for (int kt = 0; kt < 16; ++kt) { s[kt] = (f32x4){0.f, 0.f, 0.f, 0.f};
        if (kt >= w && kt <= w + 8) {
#pragma unroll
            for (int ks = 0; ks < 4; ++ks) { const bf16x8 a = *(const LAS bf16x8*)(KT + (16 * kt + (lane & 15)) * 272 + (32 * ks + 8 * g) * 2); s[kt] = mfma16(a, qf[ks], s[kt]); } } }
    float mx = -INFINITY;
#pragma unroll
    for (int kt = 0; kt < 16; ++kt)
#pragma unroll
        for (int rg = 0; rg < 4; ++rg) { const int key = 16 * kt + 4 * g + rg; const bool ok = key >= qi && key <= qi + 128 && (nb > 0 || key >= 128);
            s[kt][rg] = ok ? s[kt][rg] : -INFINITY; mx = fmaxf(mx, s[kt][rg]); }
    mx = fmaxf(mx, __shfl_xor(mx, 16)); mx = fmaxf(mx, __shfl_xor(mx, 32));
    float l = 0.f;
#pragma unroll
    for (int kt = 0; kt < 16; ++kt)
#pragma unroll
        for (int rg = 0; rg < 4; ++rg) { const float p = fexp2(s[kt][rg] - mx); s[kt][rg] = p; l += p; }
    l += __shfl_xor(l, 16); l += __shfl_xor(l, 32);
    f32x4 o[8];
#pragma unroll
    for (int ne = 0; ne < 8; ++ne) o[ne] = (f32x4){0.f, 0.f, 0.f, 0.f};
#pragma unroll
    for (int kp = 0; kp < 8; ++kp) {
        if (2 * kp + 1 < w || 2 * kp > w + 8) continue;
        bf16x8 pf; { const u32x4 wv = pack8(s[2 * kp], s[2 * kp + 1]); pf = __builtin_bit_cast(bf16x8, wv); }
        const int r0 = 32 * kp + 4 * g + q4;
#pragma unroll
        for (int ne = 0; ne < 8; ++ne) { const bf16x8 a = cat8(tr16(VT + r0 * 272 + (16 * ne) * 2 + 8 * p4), tr16(VT + (r0 + 16) * 272 + (16 * ne) * 2 + 8 * p4)); o[ne] = mfma16(a, pf, o[ne]); }
    }
    const float linv = frcp(l);
    bf16_t* OG = WSP(bf16_t, WS_OG) + qrow * AW + col0 + 4 * g;
#pragma unroll
    for (int ne = 0; ne < 8; ++ne) { const f32x4 v = o[ne] * linv; *(u32x2*)(OG + 16 * ne) = (u32x2){cvt_pk_bf16(v[0], v[1]), cvt_pk_bf16(v[2], v[3])}; }
    if (g == 0) WSP(float, WS_LSE)[qrow * 12 + grp * 4 + head] = (mx + flog2(l)) * LN2;
}

__device__ __forceinline__ void samp_state_task(const Ctx& C, int task) {
    const int bs = task >> 3, h = (task >> 1) & 3, vh = task & 1, tid = opaque(C.tid), cg4 = tid & 63, rg = tid >> 6;
    LAS float* qs = (LAS float*)C.lds; LAS float* ks = qs + 256; LAS float* red = ks + 256;
    const size_t row = TP + bs;
    __syncthreads();
    if (tid < 256) { qs[tid] = bf2f(WSP(const bf16_t, WS_QR)[row * DM + h * 256 + tid]); ks[tid] = bf2f(WSP(const bf16_t, WS_KR)[row * DM + h * 256 + tid]); }
    const bf16_t* vp = WSP(const bf16_t, WS_VR) + row * RV + h * 512 + vh * 256 + cg4 * 4;
    const u32x2 vw = *(const u32x2*)vp; const f32x4 vv = (f32x4){bflo(vw.x), bfhi(vw.x), bflo(vw.y), bfhi(vw.y)};
    const float gam = 1.0f - exp2f(-(float)(5 + h));
    const size_t sbase = ((size_t)(bs * 4 + h) * 256) * 512 + vh * 256 + cg4 * 4;
    const float* S0 = C.ka->in[2] + sbase; float* S1 = C.out + O_SS + sbase;
    __syncthreads();
    f32x4 oacc = (f32x4){0.f, 0.f, 0.f, 0.f};
#pragma unroll 8
    for (int i = 0; i < 32; ++i) { const int d = rg + 8 * i; const f32x4 s0 = *(const f32x4*)(S0 + (size_t)d * 512); const f32x4 sn = s0 * gam + vv * ks[d]; *(f32x4*)(S1 + (size_t)d * 512) = sn; oacc += sn * qs[d]; }
    *(LAS f32x4*)(red + rg * 256 + cg4 * 4) = oacc;
    __syncthreads();
    if (tid < 256) { float s = 0.f;
#pragma unroll
        for (int k = 0; k < 8; ++k) s += red[k * 256 + tid];
        WSP(float, WS_OS)[(size_t)(bs * 4 + h) * 512 + vh * 256 + tid] = s; }
}

__device__ __forceinline__ void samp_attn_wave(const Ctx& C, int wt) {
    const int bs = wt / 12, grp = (wt % 12) >> 2, head = wt & 3, lane = opaque(C.lane);
    const int dil = 1 << (2 * grp), Wb = 128 * dil; const size_t row = TP + bs; const int col0 = grp * 512 + head * 128;
    const float *c3 = C.ka->in[3], *c4 = C.ka->in[4], *c5 = C.ka->in[5];
    asm volatile("" : "+s"(c3), "+s"(c4), "+s"(c5));
    const float* cache = (grp == 0 ? c3 : grp == 1 ? c4 : c5) + (size_t)bs * Wb * 1024 + head * 128;
    LAS float* qs = (LAS float*)(C.lds + 65536 + C.wave * 2048);
    LAS float* ps = qs + 128;
    const unsigned qw = *(const unsigned*)(WSP(const bf16_t, WS_QA) + row * AW + col0 + 2 * lane); const float q0 = bflo(qw), q1 = bfhi(qw);
    const unsigned kw = *(const unsigned*)(WSP(const bf16_t, WS_KA) + row * AW + col0 + 2 * lane);
    const unsigned vw = *(const unsigned*)(WSP(const bf16_t, WS_VA) + row * AW + col0 + 2 * lane);
    *(LAS f32x2*)(qs + 2 * lane) = (f32x2){q0, q1};
    const float snew = wave_sum(q0 * bflo(kw) + q1 * bfhi(kw));
    const float* k0p = cache + (size_t)(Wb - dil * (lane + 1)) * 1024; const float* k1p = cache + (size_t)(Wb - dil * (lane + 65)) * 1024;
    float d0 = 0.f, d1 = 0.f;
#pragma unroll 8
    for (int c = 0; c < 32; ++c) { const f32x4 qq = *(const LAS f32x4*)(qs + 4 * c); const f32x4 a = *(const f32x4*)(k0p + 4 * c), bb = *(const f32x4*)(k1p + 4 * c);
        d0 += (qq[0] * a[0] + qq[1] * a[1]) + (qq[2] * a[2] + qq[3] * a[3]); d1 += (qq[0] * bb[0] + qq[1] * bb[1]) + (qq[2] * bb[2] + qq[3] * bb[3]); }
    float mx = fmaxf(fmaxf(d0, d1), snew);
#pragma unroll
    for (int o = 1; o < 64; o <<= 1) mx = fmaxf(mx, __shfl_xor(mx, o));
    const float p0 = fexp2(d0 - mx), p1 = fexp2(d1 - mx), pn = fexp2(snew - mx);
    const float l = wave_sum(p0 + p1) + pn;
    ps[lane + 1] = p0; ps[lane + 65] = p1; if (lane == 0) ps[0] = pn;
    float o0 = pn * bflo(vw), o1 = pn * bfhi(vw);
    const float* vbase = cache + 512 + 2 * lane;
#pragma unroll 1
    for (int m0 = 1; m0 <= 128; m0 += 16) {
        f32x2 vv[16];
#pragma unroll
        for (int u = 0; u < 16; ++u) vv[u] = *(const f32x2*)(vbase + (size_t)(Wb - dil * (m0 + u)) * 1024);
#pragma unroll
        for (int u = 0; u < 16; ++u) { const float p = ps[m0 + u]; o0 += p * vv[u][0]; o1 += p * vv[u][1]; }
    }
    const float linv = frcp(l);
    *(unsigned*)(WSP(bf16_t, WS_OG) + row * AW + col0 + 2 * lane) = cvt_pk_bf16(o0 * linv, o1 * linv);
    if (lane == 0) WSP(float, WS_LSE)[row * 12 + grp * 4 + head] = (mx + flog2(l)) * LN2;
}

__device__ __forceinline__ void ret_out_task(const Ctx& C, int task) {
    const int bh = task >> 5, c = task & 31, b = bh >> 2, h = bh & 3, lane = opaque(C.lane), tid = opaque(C.tid), w = C.wave, g = lane >> 4, q4 = (lane & 15) >> 2, p4 = lane & 3, l15 = lane & 15;
    const size_t r0 = (size_t)b * SEQ + c * 128;
    const bf16_t* QR = WSP(const bf16_t, WS_QR) + r0 * DM + h * 256; const bf16_t* KR = WSP(const bf16_t, WS_KR) + r0 * DM + h * 256;
    const bf16_t* VR = WSP(const bf16_t, WS_VR) + r0 * RV + h * 512;
    const bf16_t* STc = WSP(const bf16_t, WS_ST) + (size_t)(bh * 31 + (c > 0 ? c - 1 : 0)) * 512 * 256;
    LAS unsigned char* QT = C.lds;
    LAS unsigned char* PT = C.lds + 18432;
    LAS unsigned char* XT = C.lds + 53248;
    const float ginv = fexp2(-128.0f * lg2_gamma(h));
    u32x4 rq[2], rx[8];
    const int t8r = tid >> 3, t8c = tid & 7, t64r = tid >> 6, t64c = tid & 63;
#define RO_LOADQ(dt_) do { _Pragma("unroll") for (int i_ = 0; i_ < 2; ++i_) rq[i_] = *(const u32x4*)(QR + (size_t)(t8r + 64 * i_) * DM + (dt_) * 64 + t8c * 8); } while (0)
#define RO_STOREQ() do { _Pragma("unroll") for (int i_ = 0; i_ < 2; ++i_) *(LAS u32x4*)(QT + (t8r + 64 * i_) * 144 + t8c * 16) = rq[i_]; } while (0)
#define RO_LOADK(dt_) do { _Pragma("unroll") for (int i_ = 0; i_ < 2; ++i_) rx[i_] = *(const u32x4*)(KR + (size_t)(t8r + 64 * i_) * DM + (dt_) * 64 + t8c * 8); } while (0)
#define RO_STOREK() do { _Pragma("unroll") for (int i_ = 0; i_ < 2; ++i_) *(LAS u32x4*)(XT + (t8r + 64 * i_) * 144 + t8c * 16) = rx[i_]; } while (0)
#define RO_LOADS(dt_) do { _Pragma("unroll") for (int i_ = 0; i_ < 8; ++i_) rx[i_] = *(const u32x4*)(STc + (size_t)(t8r + 64 * i_) * 256 + (dt_) * 64 + t8c * 8); } while (0)
#define RO_STORES() do { _Pragma("unroll") for (int i_ = 0; i_ < 8; ++i_) *(LAS u32x4*)(XT + (t8r + 64 * i_) * 144 + t8c * 16) = rx[i_]; } while (0)
#define RO_LOADV(j_) do { _Pragma("unroll") for (int i_ = 0; i_ < 8; ++i_) rx[i_] = *(const u32x4*)(VR + (size_t)((j_) * 64 + t64r + 8 * i_) * RV + t64c * 8); } while (0)
#define RO_STOREV() do { _Pragma("unroll") for (int i_ = 0; i_ < 8; ++i_) *(LAS u32x4*)(XT + (t64r + 8 * i_) * 1040 + t64c * 16) = rx[i_]; } while (0)
    __syncthreads();
    RO_LOADQ(0); RO_LOADK(0); RO_STOREQ(); RO_STOREK();
    __syncthreads();
    {
        f32x4 a1[8];
#pragma unroll
        for (int jt = 0; jt < 8; ++jt) a1[jt] = (f32x4){0.f, 0.f, 0.f, 0.f};
#pragma unroll 1
        for (int dt = 0; dt < 4; ++dt) {
            if (dt < 3) { RO_LOADQ(dt + 1); RO_LOADK(dt + 1); } else if (c > 0) { RO_LOADQ(0); RO_LOADS(0); } else { RO_LOADV(0); }
#pragma unroll
            for (int ks = 0; ks < 2; ++ks) {
                const bf16x8 bq = *(const LAS bf16x8*)(QT + (16 * w + l15) * 144 + (32 * ks + 8 * g) * 2);
#pragma unroll
                for (int jt = 0; jt < 8; ++jt) if (jt <= w) { const bf16x8 ak = *(const LAS bf16x8*)(XT + (16 * jt + l15) * 144 + (32 * ks + 8 * g) * 2); a1[jt] = mfma16(ak, bq, a1[jt]); }
            }
            if (dt == 3) {
                const int i = 16 * w + l15;
#pragma unroll
                for (int jt = 0; jt < 8; ++jt) { f32x4 v = a1[jt] * ginv;
#pragma unroll
                    for (int rg = 0; rg < 4; ++rg) { const int j = 16 * jt + 4 * g + rg; if (jt > w || j > i) v[rg] = 0.f; }
                    *(LAS u32x2*)(PT + i * 272 + (16 * jt + 4 * g) * 2) = (u32x2){cvt_pk_bf16(v[0], v[1]), cvt_pk_bf16(v[2], v[3])}; }
            }
            __syncthreads();
            if (dt < 3) { RO_STOREQ(); RO_STOREK(); } else if (c > 0) { RO_STOREQ(); RO_STORES(); } else { RO_STOREV(); }
            __syncthreads();
        }
    }
    f32x4 a2[8][4];
#pragma unroll
    for (int it = 0; it < 8; ++it)
#pragma unroll
        for (int vt = 0; vt < 4; ++vt) a2[it][vt] = (f32x4){0.f, 0.f, 0.f, 0.f};
    if (c > 0) {
#pragma unroll 1
        for (int dt = 0; dt < 4; ++dt) {
            if (dt < 3) { RO_LOADQ(dt + 1); RO_LOADS(dt + 1); } else { RO_LOADV(0); }
#pragma unroll
            for (int ks = 0; ks < 2; ++ks) {
                bf16x8 A[4];
#pragma unroll
                for (int vt = 0; vt < 4; ++vt) A[vt] = *(const LAS bf16x8*)(XT + (64 * w + 16 * vt + l15) * 144 + (32 * ks + 8 * g) * 2);
#pragma unroll
                for (int it = 0; it < 8; ++it) { const bf16x8 B = *(const LAS bf16x8*)(QT + (16 * it + l15) * 144 + (32 * ks + 8 * g) * 2);
#pragma unroll
                    for (int vt = 0; vt < 4; ++vt) a2[it][vt] = mfma16(A[vt], B, a2[it][vt]); }
            }
            __syncthreads();
            if (dt < 3) { RO_STOREQ(); RO_STORES(); } else { RO_STOREV(); }
            __syncthreads();
        }
    }
#pragma unroll 1
    for (int jt2 = 0; jt2 < 2; ++jt2) {
        if (jt2 == 0) RO_LOADV(1);
#pragma unroll
        for (int ks = 0; ks < 2; ++ks) {
            bf16x8 A[4];
            const int rr = 32 * ks + 8 * g + q4;
#pragma unroll
            for (int vt = 0; vt < 4; ++vt) A[vt] = cat8(tr16(XT + rr * 1040 + (64 * w + 16 * vt) * 2 + 8 * p4), tr16(XT + (rr + 4) * 1040 + (64 * w + 16 * vt) * 2 + 8 * p4));
#pragma unroll
            for (int it = 0; it < 8; ++it) { const bf16x8 B = *(const LAS bf16x8*)(PT + (16 * it + l15) * 272 + (jt2 * 64 + 32 * ks + 8 * g) * 2);
#pragma unroll
                for (int vt = 0; vt < 4; ++vt) a2[it][vt] = mfma16(A[vt], B, a2[it][vt]); }
        }
        __syncthreads();
        if (jt2 == 0) { RO_STOREV(); __syncthreads(); }
    }
#undef RO_LOADQ
#undef RO_STOREQ
#undef RO_LOADK
#undef RO_STOREK
#undef RO_LOADS
#undef RO_STORES
#undef RO_LOADV
#undef RO_STOREV
    LAS float* red = (LAS float*)C.lds;
#pragma unroll
    for (int it = 0; it < 8; ++it) { float s = 0.f;
#pragma unroll
        for (int vt = 0; vt < 4; ++vt) s += (a2[it][vt][0] * a2[it][vt][0] + a2[it][vt][1] * a2[it][vt][1]) + (a2[it][vt][2] * a2[it][vt][2] + a2[it][vt][3] * a2[it][vt][3]);
        s += __shfl_xor(s, 16); s += __shfl_xor(s, 32);
        if (g == 0) red[w * 128 + 16 * it + l15] = s; }
    __syncthreads();
    const float* gn = C.ka->in[8] + h * 512; const bf16_t* GS = WSP(const bf16_t, WS_GS) + r0 * RV + h * 512; bf16_t* APA = WSP(bf16_t, WS_APA) + r0 * RV + h * 512;
#pragma unroll
    for (int it = 0; it < 8; ++it) { const int i = 16 * it + l15; float s = 0.f;
#pragma unroll
        for (int k = 0; k < 8; ++k) s += red[k * 128 + i];
        const float rinv = rsqrtf(s * (1.0f / 512.0f) + EPS);
#pragma unroll
        for (int vt = 0; vt < 4; ++vt) { const int v = 64 * w + 16 * vt + 4 * g; const f32x4 gg = *(const f32x4*)(gn + v); const u32x2 gw = *(const u32x2*)(GS + (size_t)i * RV + v);
            const f32x4 y = a2[it][vt] * rinv * gg; *(u32x2*)(APA + (size_t)i * RV + v) = (u32x2){cvt_pk_bf16(y[0] * bflo(gw.x), y[1] * bfhi(gw.x)), cvt_pk_bf16(y[2] * bflo(gw.y), y[3] * bfhi(gw.y))}; }
        asm volatile("" ::: "memory");
    }
}
__device__ __forceinline__ void combine_row(const Ctx& C, int row) {
    const int lane = opaque(C.lane), slot = lane >> 4;
    const float* ls = WSP(const float, WS_LSE) + (size_t)row * 12 + slot; const float l0 = ls[0], l1 = ls[4], l2 = ls[8];
    const float mx = fmaxf(l0, fmaxf(l1, l2)); const float e0 = fexp2((l0 - mx) * 1.4426950408889634f), e1 = fexp2((l1 - mx) * 1.4426950408889634f), e2 = fexp2((l2 - mx) * 1.4426950408889634f);
    const float inv = frcp(e0 + e1 + e2);
    const bf16_t* og = WSP(const bf16_t, WS_OG) + (size_t)row * AW + lane * 8;
    f32x4 a0, a1, b0, b1, c0, c1; unpack8(*(const u32x4*)og, a0, a1); unpack8(*(const u32x4*)(og + 512), b0, b1); unpack8(*(const u32x4*)(og + 1024), c0, c1);
    const f32x4 r0 = (a0 * e0 + b0 * e1 + c0 * e2) * inv, r1 = (a1 * e0 + b1 * e1 + c1 * e2) * inv;
    *(u32x4*)(WSP(bf16_t, WS_OA) + (size_t)row * AOUT + lane * 8) = pack8(r0, r1);
}
__device__ __forceinline__ void samp_fin_wave(const Ctx& C, int wt) {
    const int bs = wt >> 2, h = wt & 3, lane = opaque(C.lane); const size_t row = TP + bs;
    const float* os = WSP(const float, WS_OS) + (size_t)wt * 512 + lane * 8;
    const f32x4 x0 = *(const f32x4*)os, x1 = *(const f32x4*)(os + 4);
    const float ss = wave_sum((x0[0] * x0[0] + x0[1] * x0[1]) + (x0[2] * x0[2] + x0[3] * x0[3]) + (x1[0] * x1[0] + x1[1] * x1[1]) + (x1[2] * x1[2] + x1[3] * x1[3]));
    const float rinv = rsqrtf(ss * (1.0f / 512.0f) + EPS);
    const float* gn = C.ka->in[8] + h * 512 + lane * 8; const f32x4 g0 = *(const f32x4*)gn, g1 = *(const f32x4*)(gn + 4);
    f32x4 s0, s1; unpack8(*(const u32x4*)(WSP(const bf16_t, WS_GS) + row * RV + h * 512 + lane * 8), s0, s1);
    *(u32x4*)(WSP(bf16_t, WS_APA) + row * RV + h * 512 + lane * 8) = pack8(x0 * rinv * g0 * s0, x1 * rinv * g1 * s1);
}


template <int MODE, int K>
__device__ __forceinline__ void skinny_task(const Ctx& C, int task, const bf16_t* A, const bf16_t* Bt) {
    const int lane = opaque(C.lane), tid = opaque(C.tid), w = C.wave, g = lane >> 4, l15 = lane & 15;
    constexpr int KW = K / 8, NS = KW / 32;
    static_assert(KW % 32 == 0, "skinny split-K");
    const bf16_t* ap = A + (size_t)(TP + l15) * K + w * KW + 8 * g;
    const bf16_t* bp = Bt + (size_t)(task * 64 + l15) * K + w * KW + 8 * g;
    f32x4 acc[2][4];
#pragma unroll
    for (int i = 0; i < 2; ++i)
#pragma unroll
        for (int j = 0; j < 4; ++j) acc[i][j] = (f32x4){0.f, 0.f, 0.f, 0.f};
#pragma unroll 4
    for (int ks = 0; ks < NS; ++ks) {
        bf16x8 a[2], b[4];
#pragma unroll
        for (int mt = 0; mt < 2; ++mt) a[mt] = *(const bf16x8*)(ap + (size_t)(16 * mt) * K + 32 * ks);
#pragma unroll
        for (int nt = 0; nt < 4; ++nt) b[nt] = *(const bf16x8*)(bp + (size_t)(16 * nt) * K + 32 * ks);
#pragma unroll
        for (int mt = 0; mt < 2; ++mt)
#pragma unroll
            for (int nt = 0; nt < 4; ++nt) acc[mt][nt] = mfma16(b[nt], a[mt], acc[mt][nt]);
    }
    LAS float* red = (LAS float*)C.lds;
    __syncthreads();
#pragma unroll
    for (int mt = 0; mt < 2; ++mt)
#pragma unroll
        for (int nt = 0; nt < 4; ++nt) *(LAS f32x4*)(red + (w * 32 + 16 * mt + l15) * 68 + 16 * nt + 4 * g) = acc[mt][nt];
    __syncthreads();
    const int r = tid >> 4, c4 = (tid & 15) * 4;
    f32x4 v = (f32x4){0.f, 0.f, 0.f, 0.f};
#pragma unroll
    for (int k = 0; k < 8; ++k) v += *(const LAS f32x4*)(red + (k * 32 + r) * 68 + c4);
    const int row = TP + r, col = task * 64 + c4; const size_t ro = (size_t)row * DM + col;
    if (MODE == 0) {
        const u32x2 gw = *(const u32x2*)(WSP(const bf16_t, WS_SGA) + ro); const f32x4 gg = (f32x4){bflo(gw.x), bfhi(gw.x), bflo(gw.y), bfhi(gw.y)};
        *(f32x4*)(WSP(float, WS_P) + ro) = v * gg;
    } else if (MODE == 1) {
        const u32x2 gw = *(const u32x2*)(WSP(const bf16_t, WS_SGB) + ro); const f32x4 gg = (f32x4){bflo(gw.x), bfhi(gw.x), bflo(gw.y), bfhi(gw.y)};
        const f32x4 m = *(const f32x4*)(WSP(const float, WS_P) + ro) + v * gg;
        *(u32x2*)(WSP(bf16_t, WS_MERGED) + ro) = (u32x2){cvt_pk_bf16(m[0], m[1]), cvt_pk_bf16(m[2], m[3])};
    } else {
        f32x4 hh;
        if (MODE == 2) { hh = *(const f32x4*)(C.ka->in[1] + (size_t)r * DM + col) + v; *(f32x4*)(WSP(float, WS_H) + ro) = hh; *(u32x2*)(WSP(bf16_t, WS_HB) + ro) = (u32x2){cvt_pk_bf16(hh[0], hh[1]), cvt_pk_bf16(hh[2], hh[3])}; }
        else { hh = *(const f32x4*)(WSP(const float, WS_H) + ro) + v; *(f32x4*)(C.out + ro) = hh; }
        float ss = (hh[0] * hh[0] + hh[1] * hh[1]) + (hh[2] * hh[2] + hh[3] * hh[3]);
        ss += __shfl_xor(ss, 1); ss += __shfl_xor(ss, 2); ss += __shfl_xor(ss, 4); ss += __shfl_xor(ss, 8);
        if ((tid & 15) == 0) WSP(float, MODE == 2 ? WS_RSS1 : WS_RSS2)[(size_t)row * 16 + task] = ss;
    }
    __syncthreads();
}

__device__ __forceinline__ void final_norm(const Ctx& C) {
    const int gw = C.bid * 8 + C.wave, NGW = C.G * 8, lane = C.lane;
    const f32x4* g4 = (const f32x4*)C.ka->in[15]; const float* RSS = WSP(const float, WS_RSS2);
    for (int row = gw; row < MR; row += NGW) {
        const f32x4* rp = (const f32x4*)(RSS + (size_t)row * 16); const f32x4 r0 = rp[0], r1 = rp[1], r2 = rp[2], r3 = rp[3];
        const float ssum = ((r0[0] + r0[1]) + (r0[2] + r0[3])) + ((r1[0] + r1[1]) + (r1[2] + r1[3])) + ((r2[0] + r2[1]) + (r2[2] + r2[3])) + ((r3[0] + r3[1]) + (r3[2] + r3[3]));
        const float rinv = rsqrtf(ssum * (1.0f / DM) + EPS);
        f32x4* y = (f32x4*)(C.out + (size_t)row * DM) + lane;
#pragma unroll
        for (int j = 0; j < 4; ++j) y[64 * j] = y[64 * j] * rinv * g4[lane + 64 * j];
    }
}


#define XB_TMO      128
#define XB_XCNT(j)  (256  + 64 * (j))
#define XB_XSUB(j)  (1280 + 64 * (j))
#define XB_XGEN(j)  (2304 + 64 * (j))
#define XB_TOP      3328
#define XB_TOPGEN   3392
#define XCD_BAR_WORDS 3456
#define XB_SPIN_CAP (1u << 18)
__device__ __forceinline__ unsigned xb_ld(unsigned* p)              { return __hip_atomic_load(p, __ATOMIC_RELAXED, __HIP_MEMORY_SCOPE_AGENT); }
__device__ __forceinline__ unsigned xb_add(unsigned* p, unsigned v) { return __hip_atomic_fetch_add(p, v, __ATOMIC_RELAXED, __HIP_MEMORY_SCOPE_AGENT); }
__device__ __forceinline__ unsigned xb_xcc_id() { return (unsigned)__builtin_amdgcn_s_getreg((3 << 11) | 20) & 0xFu; }
#define XB_SPIN(cond, bar) do { unsigned _sp = 0; while (cond) { __builtin_amdgcn_s_sleep(1); \
    if ((++_sp & 255u) == 0u) { if (xb_ld(&(bar)[XB_TMO])) break; if (_sp > XB_SPIN_CAP) { atomicAdd(&(bar)[XB_TMO], 1u); break; } } } } while (0)
struct XcdBarrier { unsigned* bar; unsigned x; volatile LAS unsigned* st; };
__device__ __forceinline__ XcdBarrier xcd_barrier_post(unsigned* bar, volatile LAS unsigned* st) {
    XcdBarrier b; b.bar = bar; b.x = xb_xcc_id(); b.st = st;
    if (threadIdx.x == 0) (void)xb_add(&bar[XB_XCNT(b.x)], 1u);
    return b;
}
__device__ __forceinline__ void xcd_barrier_complete(unsigned* bar, unsigned x, unsigned& nloc, unsigned& nx) {
    const unsigned G = gridDim.x * gridDim.y * gridDim.z;
    unsigned sum, cnt, mine, sp = 0u;
    for (;;) {
        sum = 0u; cnt = 0u; mine = 0u;
#pragma unroll
        for (unsigned j = 0; j < 16; ++j) { const unsigned c = xb_ld(&bar[XB_XCNT(j)]); sum += c; cnt += (c > 0u) ? 1u : 0u; mine = (j == x) ? c : mine; }
        if (sum == G) break;
        __builtin_amdgcn_s_sleep(1);
        if ((++sp & 255u) == 0u) { if (xb_ld(&bar[XB_TMO])) break; if (sp > XB_SPIN_CAP) { atomicAdd(&bar[XB_TMO], 1u); break; } }
    }
    nloc = mine > 0u ? mine : 1u; nx = cnt > 0u ? cnt : 1u;
}
__device__ __forceinline__ void xcd_barrier(const XcdBarrier& b) {
    asm volatile("s_waitcnt vmcnt(0)" ::: "memory");
    __syncthreads();
    if (threadIdx.x == 0) {
        unsigned* bar = b.bar;
        __builtin_amdgcn_s_waitcnt(0);
        unsigned nloc = b.st[0], nx = b.st[1];
        if (nloc == 0u) { xcd_barrier_complete(bar, b.x, nloc, nx); b.st[0] = nloc; b.st[1] = nx; }
        const unsigned old = xb_add(&bar[XB_XSUB(b.x)], 1u);
        const unsigned gen = old / nloc;
        if (old + 1u == (gen + 1u) * nloc) {
            __builtin_amdgcn_fence(__ATOMIC_RELEASE, "agent");
            asm volatile("s_waitcnt vmcnt(0)" ::: "memory");
            const unsigned og = xb_add(&bar[XB_TOP], 1u);
            const unsigned tg = og / nx;
            if (og + 1u == (tg + 1u) * nx) xb_add(&bar[XB_TOPGEN], 1u);
            else XB_SPIN(xb_ld(&bar[XB_TOPGEN]) == tg, bar);
            __builtin_amdgcn_fence(__ATOMIC_ACQUIRE, "agent");
            xb_add(&bar[XB_XGEN(b.x)], 1u);
            asm volatile("s_waitcnt vmcnt(0)" ::: "memory");
        } else {
            XB_SPIN(xb_ld(&bar[XB_XGEN(b.x)]) == gen, bar);
            __builtin_amdgcn_fence(__ATOMIC_ACQUIRE, "agent");
            asm volatile("s_waitcnt vmcnt(0)" ::: "memory");
        }
    }
    __syncthreads();
}

template <int PH_LO, int PH_HI, int P2MASK = 15>
__global__ void __launch_bounds__(512, 2) mk_fwd(Args args) {
    extern __shared__ __attribute__((aligned(16))) unsigned char lds_raw[];
    Ctx C; C.lds = (LAS unsigned char*)lds_raw; C.tid = threadIdx.x; C.lane = C.tid & 63; C.wave = __builtin_amdgcn_readfirstlane(C.tid >> 6); C.G = gridDim.x; C.bid = blockIdx.x;
    C.ka = (const __attribute__((address_space(4))) Args*)__builtin_amdgcn_kernarg_segment_ptr();
    C.out = args.out; C.ws = args.ws;
    unsigned* ctl = (unsigned*)(C.ws + WS_CTL);
    constexpr int lo = PH_LO, hi = PH_HI;
#if MK_FUSED
    cg::grid_group grid = cg::this_grid();
    if (C.tid < 8) ((LAS unsigned*)(C.lds + LDS_MISC))[C.tid] = 0u;
    __syncthreads();
    const XcdBarrier xbar = xcd_barrier_post(ctl + CW_BAR, (volatile LAS unsigned*)(C.lds + LDS_MISC + 16));
#define SEAM(k) do { if constexpr (lo <= (k) && (k) + 1 < hi) { if constexpr ((k) == 0) grid.sync(); else xcd_barrier(xbar); } } while (0)
#else
#define SEAM(k) do { } while (0)
#endif
#define IN(k) constexpr (lo <= (k) && (k) < hi)
    if IN(0) { p0_prep(C); }
    SEAM(0);
    if IN(1) {
        pg8::Gemm g{WSP(const bf16_t, WS_XN), WSP(const bf16_t, WS_WIN), MP, NIN, DM}; pg8::StaticOrder S; S.init(MP, NIN, C.G, C.bid);
        EpiIn E{C.ws, WSP(const float, WS_ROPEC), WSP(const float, WS_ROPES), C.out};
        pg8::gemm_phase<EpiIn, pg8::StaticOrder, true, true>(C.lds, g, S, E);
    }
    SEAM(1);
    if IN(2) {
        if (C.bid < 128 && C.G >= 128) { if (P2MASK & 1) { const int bhl = C.bid & 7, j = C.bid >> 3, sl = j & 7, bh = bhl + 8 * (j >> 3); ret_chain_task(C, bh * 8 + sl); } }
        else if (C.G < 128) { if (P2MASK & 1) for (int t = C.bid; t < 128; t += C.G) ret_chain_task(C, t); }
        int id = wq_first(C, ctl + CW_Q2);
        while (id < 1840) {
            const unsigned nxt = wq_prefetch(C, ctl + CW_Q2);
            if (id < 1536) { if (P2MASK & 2) attn_unit(C, id); }
            else if (id < 1536 + 256) { if (P2MASK & 4) samp_state_task(C, id - 1536); }
            else { if (P2MASK & 8) samp_attn_wave(C, (id - 1792) * 8 + C.wave); }
            id = wq_take(C, nxt);
        }
    }
    SEAM(2);
    if IN(3) {
        int id = wq_first(C, ctl + CW_Q3);
        while (id < 593) {
            const unsigned nxt = wq_prefetch(C, ctl + CW_Q3);
            if (id < 512) ret_out_task(C, id);
            else if (id < 512 + 65) { const int r0 = (id - 512) * 256 + C.wave * 32; for (int r = 0; r < 32; ++r) if (r0 + r < MR) combine_row(C, r0 + r); }
            else samp_fin_wave(C, (id - 577) * 8 + C.wave);
            id = wq_take(C, nxt);
        }
    }
    SEAM(3);
    if IN(4) {
        for (int t = C.bid; t < 16; t += C.G) skinny_task<0, RV>(C, t, WSP(const bf16_t, WS_APA), WSP(const bf16_t, WS_WPA));
        pg8::Gemm g{WSP(const bf16_t, WS_APA), WSP(const bf16_t, WS_WPA), TP, DM, RV}; pg8::StaticOrder S; S.init(TP, DM, C.G, C.bid);
        EpiPa E{WSP(const bf16_t, WS_SGA), WSP(float, WS_P)};
        pg8::gemm_phase<EpiPa, pg8::StaticOrder, true, true>(C.lds, g, S, E);
    }
    if IN(5) {
        for (int t = C.bid; t < 16; t += C.G) skinny_task<1, AOUT>(C, t, WSP(const bf16_t, WS_OA), WSP(const bf16_t, WS_WPB));
        pg8::Gemm g{WSP(const bf16_t, WS_OA), WSP(const bf16_t, WS_WPB), TP, DM, AOUT}; pg8::StaticOrder S; S.init(TP, DM, C.G, C.bid);
        EpiPb E{WSP(const bf16_t, WS_SGB), WSP(const float, WS_P), WSP(bf16_t, WS_MERGED)};
        pg8::gemm_phase<EpiPb, pg8::StaticOrder, true, true>(C.lds, g, S, E);
    }
    SEAM(5);
    if IN(6) {
        for (int t = C.bid; t < 16; t += C.G) skinny_task<2, DM>(C, t, WSP(const bf16_t, WS_MERGED), WSP(const bf16_t, WS_WO));
        pg8::Gemm g{WSP(const bf16_t, WS_MERGED), WSP(const bf16_t, WS_WO), TP, DM, DM}; pg8::StaticOrder S; S.init(TP, DM, C.G, C.bid);
        EpiO E{C.ka->in[0], C.ka->in[1], WSP(float, WS_H), WSP(bf16_t, WS_HB), WSP(float, WS_RSS1)};
        pg8::gemm_phase<EpiO, pg8::StaticOrder, true, true>(C.lds, g, S, E);
    }
    SEAM(6);
    if IN(7) {
        pg8::Gemm g{WSP(const bf16_t, WS_HB), WSP(const bf16_t, WS_WFI), MP, 2 * FH, DM}; pg8::StaticOrder S; S.init(MP, 2 * FH, C.G, C.bid);
        EpiFi E{WSP(const float, WS_RSS1), WSP(bf16_t, WS_HID)};
        pg8::gemm_phase<EpiFi, pg8::StaticOrder, true, true>(C.lds, g, S, E);
    }
    SEAM(7);
    if IN(8) {
        for (int t = C.bid; t < 16; t += C.G) skinny_task<3, FH>(C, t, WSP(const bf16_t, WS_HID), WSP(const bf16_t, WS_WFO));
        pg8::Gemm g{WSP(const bf16_t, WS_HID), WSP(const bf16_t, WS_WFO), TP, DM, FH}; pg8::StaticOrder S; S.init(TP, DM, C.G, C.bid);
        EpiFo E{WSP(const float, WS_H), C.out, WSP(float, WS_RSS2)};
        pg8::gemm_phase<EpiFo, pg8::StaticOrder, true, true>(C.lds, g, S, E);
    }
    SEAM(8);
    if IN(9) final_norm(C);
#undef IN
#undef SEAM
}

template <int LO, int HI, int MASK = 15> static void launch_range(int grid, const Args& a, hipStream_t stream) {
    static bool attr = false;
    if (!attr) { (void)hipFuncSetAttribute((const void*)mk_fwd<LO, HI, MASK>, hipFuncAttributeMaxDynamicSharedMemorySize, LDS_BYTES); attr = true; }
    hipLaunchKernelGGL((mk_fwd<LO, HI, MASK>), dim3(grid), dim3(512), LDS_BYTES, stream, a);
}
extern "C" void kernel_launch(void* const* d_in, const int* in_sizes, int n_in, void* d_out, int out_size, void* d_ws, size_t ws_size, hipStream_t stream) {
    static int grid = 0;
    if (grid == 0) {
        if (n_in != 16 || out_size != (int)O_END || ws_size < WS_END) { fprintf(stderr, "kernel_launch: unexpected shapes (n_in %d out %d ws %zu)\n", n_in, out_size, ws_size); grid = -1; return; }
        int dev = 0, cus = 0;
        (void)hipGetDevice(&dev); (void)hipDeviceGetAttribute(&cus, hipDeviceAttributeMultiprocessorCount, dev);
#if MK_FUSED
        int per_cu = 0;
        (void)hipFuncSetAttribute((const void*)mk_fwd<0, 10>, hipFuncAttributeMaxDynamicSharedMemorySize, LDS_BYTES);
        (void)hipOccupancyMaxActiveBlocksPerMultiprocessor(&per_cu, (const void*)mk_fwd<0, 10>, 512, LDS_BYTES);
        if (per_cu < 1) { fprintf(stderr, "kernel_launch: occupancy query says %d blocks per CU\n", per_cu); grid = -1; return; }
#endif
        (void)hipGetLastError();
        grid = cus;
    }
    if (grid < 0) return;
    (void)hipMemsetAsync((char*)d_ws + WS_CTL, 0, CTL_BYTES, stream);
    Args a{};
    for (int i = 0; i < 16; ++i) a.in[i] = (const float*)d_in[i];
    a.out = (float*)d_out; a.ws = (unsigned char*)d_ws;
#if MK_FUSED
    void* kargs[] = {&a};
    hipError_t e = hipLaunchCooperativeKernel((const void*)mk_fwd<0, 10>, dim3(grid), dim3(512), kargs, LDS_BYTES, stream);
    if (e != hipSuccess) fprintf(stderr, "cooperative launch failed: %s (grid %d)\n", hipGetErrorString(e), grid);
#else
#ifndef PROBE_REP
#define PROBE_REP -1
#endif
#ifndef PROBE_P2MASK
#define PROBE_P2MASK 0
#endif
#define REP(k, stmt) do { stmt; if (PROBE_REP == (k)) { (void)hipMemsetAsync((char*)d_ws + WS_CTL, 0, CTL_BYTES, stream); stmt; } } while (0)
    REP(0, (launch_range<0, 1>(grid, a, stream))); REP(1, (launch_range<1, 2>(grid, a, stream))); REP(2, (launch_range<2, 3>(grid, a, stream)));
    if (PROBE_P2MASK) { (void)hipMemsetAsync((char*)d_ws + WS_CTL, 0, CTL_BYTES, stream); launch_range<2, 3, PROBE_P2MASK ? PROBE_P2MASK : 15>(grid, a, stream); }
    REP(3, (launch_range<3, 4>(grid, a, stream)));
    REP(4, (launch_range<4, 6>(grid, a, stream))); REP(6, (launch_range<6, 7>(grid, a, stream))); REP(7, (launch_range<7, 8>(grid, a, stream))); REP(8, (launch_range<8, 9>(grid, a, stream))); launch_range<9, 10>(grid, a, stream);
#endif
}
```
